# Optimizing an MI355X kernel written in HIP

```python
import jax
import jax.numpy as jnp
from jax import lax
import numpy as np

D_MODEL = 1024
BATCH = 4
SEQ = 8192
DEPTH = 2

GRID_W = 64
CTX_LEN = 256
D_FF = 4 * D_MODEL
NORM_EPS = 1e-6
ROPE_THETA = 10000.0
Q_BLOCK = 128
N_MOD = 6

MLA_HEADS = 8
MLA_Q_RANK = 256
MLA_KV_RANK = 128
MLA_NOPE = 64
MLA_ROPE = 32
MLA_V = 64

ML_HEADS = 4
ML_DK = 128
ML_DV = 128
ML_CONV = 3
ML_CHUNK = 128
ML_F_BIAS_LO = 3.0
ML_F_BIAS_HI = 6.0

GQA_HEADS = 8
GQA_KV_HEADS = 2
GQA_GROUP = GQA_HEADS // GQA_KV_HEADS
GQA_DH = 128

N_GATES = 4 * ML_HEADS
EVEN_WIDTHS = (MLA_Q_RANK, MLA_KV_RANK, MLA_ROPE, 2 * ML_HEADS * ML_DK, ML_HEADS * ML_DV, ML_HEADS * ML_DV, N_GATES)
EVEN_SPLITS = tuple(int(s) for s in np.cumsum(EVEN_WIDTHS)[:-1])
EVEN_IN = sum(EVEN_WIDTHS)
EVEN_MIX = MLA_HEADS * MLA_V + ML_HEADS * ML_DV
ODD_SPLITS = (GQA_HEADS * GQA_DH, (GQA_HEADS + GQA_KV_HEADS) * GQA_DH)
ODD_IN = (GQA_HEADS + 2 * GQA_KV_HEADS) * GQA_DH
ODD_MIX = GQA_HEADS * GQA_DH

kernel_name = 'hybrid_mla_mlstm_gqa_dit_block'


def rms_norm(x, g):
    xf = x.astype(jnp.float32)
    y = xf * lax.rsqrt(jnp.mean(xf * xf, axis=-1, keepdims=True) + NORM_EPS)
    return (y * g.astype(jnp.float32)).astype(x.dtype)


def modulate(x, g, shift, scale):
    return rms_norm(x, g) * (1 + scale[:, None, :]) + shift[:, None, :]


def adaln(cvec, ada_w, ada_b):
    return jnp.split(jax.nn.silu(cvec) @ ada_w + ada_b, N_MOD, axis=-1)


def grid_angles(n_tokens, d_rot):
    rows = n_tokens // GRID_W
    row, col = jnp.meshgrid(jnp.arange(rows), jnp.arange(GRID_W), indexing='ij')
    pos = jnp.stack([row.reshape(-1), col.reshape(-1)], axis=-1).astype(jnp.float32)
    n_freq = d_rot // 4
    freqs = ROPE_THETA ** (-jnp.arange(n_freq, dtype=jnp.float32) / n_freq)
    return pos[:, :, None] * freqs


def apply_rope(x, ang):
    xr = x.reshape(x.shape[:-1] + (2, 2, ang.shape[-1]))
    x0, x1 = xr[..., 0, :], xr[..., 1, :]
    cos = jnp.cos(ang).astype(x.dtype)
    sin = jnp.sin(ang).astype(x.dtype)
    out = jnp.stack([x0 * cos - x1 * sin, x1 * cos + x0 * sin], axis=-2)
    return out.reshape(x.shape)


def block_attention(q, k, v, scale):
    B, Hk, G, T, dq = q.shape
    nb = T // Q_BLOCK
    qb = jnp.moveaxis(q.reshape(B, Hk, G, nb, Q_BLOCK, dq), 3, 0)

    def one_block(qblk):
        s = jnp.einsum('bhgqd,bhkd->bhgqk', qblk, k, preferred_element_type=jnp.float32) * scale
        p = jax.nn.softmax(s, axis=-1)
        return jnp.einsum('bhgqk,bhkd->bhgqd', p.astype(v.dtype), v)

    out = lax.map(one_block, qb)
    return jnp.moveaxis(out, 0, 3).reshape(B, Hk, G, T, v.shape[-1])


def merge_heads(o):
    B, T = o.shape[0], o.shape[3]
    return o.transpose(0, 3, 1, 2, 4).reshape(B, T, -1)


def short_conv(x, w):
    pad = w.shape[0] // 2
    return lax.conv_general_dilated(x, w[:, None, :].astype(x.dtype), window_strides=(1,), padding=[(pad, pad)],
                                    dimension_numbers=('NWC', 'WIO', 'NWC'), feature_group_count=x.shape[-1])


def mla_q(cq_pre, q_norm, w_uq, ang):
    B, T = cq_pre.shape[:2]
    q = (rms_norm(cq_pre, q_norm) @ w_uq).reshape(B, T, MLA_HEADS, MLA_NOPE + MLA_ROPE).transpose(0, 2, 1, 3)
    q_pe = q[..., MLA_NOPE:]
    if ang is not None:
        q_pe = apply_rope(q_pe, ang)
    return jnp.concatenate([q[..., :MLA_NOPE], q_pe], axis=-1)[:, :, None]


def mla_kv(ckv_pre, k_pe, kv_norm, w_ukv, ang):
    B, T = ckv_pre.shape[:2]
    kv = (rms_norm(ckv_pre, kv_norm) @ w_ukv).reshape(B, T, MLA_HEADS, MLA_NOPE + MLA_V).transpose(0, 2, 1, 3)
    k_pe = k_pe[:, None]
    if ang is not None:
        k_pe = apply_rope(k_pe, ang)
    k_pe = jnp.broadcast_to(k_pe, (B, MLA_HEADS, T, MLA_ROPE))
    k = jnp.concatenate([kv[..., :MLA_NOPE], k_pe], axis=-1)
    return k, kv[..., MLA_NOPE:]


def mla_mixer(px, pc, q_norm, w_uq, kv_norm, w_ukv, ang, with_ctx):
    scale = (MLA_NOPE + MLA_ROPE) ** -0.5
    kc, vc = mla_kv(pc[1], pc[2], kv_norm, w_ukv, None)
    kx, vx = mla_kv(px[1], px[2], kv_norm, w_ukv, ang)
    qx = mla_q(px[0], q_norm, w_uq, ang)
    out_x = merge_heads(block_attention(qx, jnp.concatenate([kc, kx], axis=2), jnp.concatenate([vc, vx], axis=2), scale))
    out_c = merge_heads(block_attention(mla_q(pc[0], q_norm, w_uq, None), kc, vc, scale)) if with_ctx else None
    return out_x, out_c


def mlstm_scan(q, k, v, log_i, log_f, state):
    B, H, T, dv = v.shape
    nc = T // ML_CHUNK

    def chunks(a):
        return jnp.moveaxis(a.reshape((B, H, nc, ML_CHUNK) + a.shape[3:]), 2, 0)

    lower = jnp.tril(jnp.ones((ML_CHUNK, ML_CHUNK), dtype=bool))

    def step(carry, xs):
        C, n, m = carry
        qc, kc, vc, li, lf = xs
        b = jnp.cumsum(lf, axis=-1)
        logw = jnp.where(lower, b[..., :, None] - b[..., None, :] + li[..., None, :], -jnp.inf)
        m_t = jnp.maximum(b + m[..., None], jnp.max(logw, axis=-1))
        w_state = jnp.exp(b + m[..., None] - m_t)
        s = jnp.einsum('bhtd,bhsd->bhts', qc, kc) * jnp.exp(logw - m_t[..., None])
        num = w_state[..., None] * jnp.einsum('bhtd,bhde->bhte', qc, C) + jnp.einsum('bhts,bhse->bhte', s, vc)
        den = w_state * jnp.einsum('bhtd,bhd->bht', qc, n) + jnp.sum(s, axis=-1)
        h = num / jnp.maximum(jnp.abs(den), jnp.exp(-m_t))[..., None]
        b_end = b[..., -1]
        g = b_end[..., None] - b + li
        m_new = jnp.maximum(b_end + m, jnp.max(g, axis=-1))
        decay = jnp.exp(b_end + m - m_new)
        wk = jnp.exp(g - m_new[..., None])[..., None] * kc
        C_new = decay[..., None, None] * C + jnp.einsum('bhsd,bhse->bhde', wk, vc)
        n_new = decay[..., None] * n + jnp.sum(wk, axis=2)
        return (C_new, n_new, m_new), h

    state, hs = lax.scan(step, state, (chunks(q), chunks(k), chunks(v), chunks(log_i), chunks(log_f)))
    return jnp.moveaxis(hs, 0, 2).reshape(B, H, T, dv), state


def mlstm_prep(p, conv_w, gate_b):
    qk_pre, v, o_pre, g = p
    B, T = v.shape[:2]
    qk = jax.nn.silu(short_conv(qk_pre, conv_w))
    q, k = jnp.split(qk, 2, axis=-1)

    def heads(a):
        return a.reshape(B, T, ML_HEADS, -1).transpose(0, 2, 1, 3).astype(jnp.float32)

    g = (g + gate_b).astype(jnp.float32).reshape(B, T, 2, 2, ML_HEADS).transpose(2, 3, 0, 4, 1)
    log_i = g[:, 0]
    log_f = jax.nn.log_sigmoid(g[:, 1])
    return heads(q) * ML_DK ** -0.5, heads(k), heads(v), o_pre, log_i, log_f


def mlstm_mixer(px, pc, conv_w, gate_b, head_norm, with_ctx):
    qx, kx, vx, ox, lix, lfx = mlstm_prep(px, conv_w, gate_b)
    qc, kc, vc, oc, lic, lfc = mlstm_prep(pc, conv_w, gate_b)
    B = qx.shape[0]
    zero = (jnp.zeros((B, ML_HEADS, ML_DK, ML_DV), jnp.float32), jnp.zeros((B, ML_HEADS, ML_DK), jnp.float32),
            jnp.zeros((B, ML_HEADS), jnp.float32))

    def rev(a):
        return jnp.flip(a, axis=2)

    hc_f, st_f = mlstm_scan(qc, kc, vc, lic[0], lfc[0], zero)
    hx_f, _ = mlstm_scan(qx, kx, vx, lix[0], lfx[0], st_f)
    hc_b, st_b = mlstm_scan(rev(qc), rev(kc), rev(vc), rev(lic[1]), rev(lfc[1]), zero)
    hx_b, _ = mlstm_scan(rev(qx), rev(kx), rev(vx), rev(lix[1]), rev(lfx[1]), st_b)

    def readout(hf, hb, o_pre):
        h = rms_norm(hf + rev(hb), head_norm.reshape(ML_HEADS, 1, ML_DV))
        return (jax.nn.sigmoid(o_pre) * merge_heads(h[:, :, None])).astype(o_pre.dtype)

    out_x = readout(hx_f, hx_b, ox)
    out_c = readout(hc_f, hc_b, oc) if with_ctx else None
    return out_x, out_c


def gqa_q(pq, q_norm, ang):
    B, T = pq.shape[:2]
    q = rms_norm(pq.reshape(B, T, GQA_KV_HEADS, GQA_GROUP, GQA_DH).transpose(0, 2, 3, 1, 4), q_norm)
    return q if ang is None else apply_rope(q, ang)


def gqa_kv(pk, pv, k_norm, ang):
    B, T = pk.shape[:2]

    def heads(a):
        return a.reshape(B, T, GQA_KV_HEADS, GQA_DH).transpose(0, 2, 1, 3)

    k = rms_norm(heads(pk), k_norm)
    if ang is not None:
        k = apply_rope(k, ang)
    return k, heads(pv)


def gqa_mixer(hx, hc, q_norm, k_norm, ang, with_ctx):
    scale = GQA_DH ** -0.5
    qx_pre, kx_pre, vx_pre = jnp.split(hx, ODD_SPLITS, axis=-1)
    qc_pre, kc_pre, vc_pre = jnp.split(hc, ODD_SPLITS, axis=-1)
    kc, vc = gqa_kv(kc_pre, vc_pre, k_norm, None)
    kx, vx = gqa_kv(kx_pre, vx_pre, k_norm, ang)
    qx = gqa_q(qx_pre, q_norm, ang)
    out_x = merge_heads(block_attention(qx, jnp.concatenate([kc, kx], axis=2), jnp.concatenate([vc, vx], axis=2), scale))
    out_c = merge_heads(block_attention(gqa_q(qc_pre, q_norm, None), kc, vc, scale)) if with_ctx else None
    return out_x, out_c


def finish_sublayers(s, mix, mods, w_out, norm2, w1, w2):
    s = s + mods[2][:, None] * (mix @ w_out)
    h = modulate(s, norm2, mods[3], mods[4])
    return s + mods[5][:, None] * (jnp.square(jax.nn.relu(h @ w1)) @ w2)


def even_layer(x, ctx, c, c_ctx, prm, ang, update_ctx):
    (ada_w, ada_b, norm1, w_in, mla_q_norm, mla_w_uq, mla_kv_norm, mla_w_ukv,
     ml_conv, ml_gate_b, ml_head_norm, w_out, norm2, w1, w2) = prm
    mx = adaln(c, ada_w, ada_b)
    mc = adaln(c_ctx[None], ada_w, ada_b)
    px = jnp.split(modulate(x, norm1, mx[0], mx[1]) @ w_in, EVEN_SPLITS, axis=-1)
    pc = jnp.split(modulate(ctx, norm1, mc[0], mc[1]) @ w_in, EVEN_SPLITS, axis=-1)
    a_x, a_c = mla_mixer(px[:3], pc[:3], mla_q_norm, mla_w_uq, mla_kv_norm, mla_w_ukv, ang, update_ctx)
    b_x, b_c = mlstm_mixer(px[3:], pc[3:], ml_conv, ml_gate_b, ml_head_norm, update_ctx)
    x = finish_sublayers(x, jnp.concatenate([a_x, b_x], axis=-1), mx, w_out, norm2, w1, w2)
    if update_ctx:
        ctx = finish_sublayers(ctx, jnp.concatenate([a_c, b_c], axis=-1), mc, w_out, norm2, w1, w2)
    return x, ctx


def odd_layer(x, ctx, c, c_ctx, prm, ang, update_ctx):
    (ada_w, ada_b, norm1, w_in, q_norm, k_norm, w_out, norm2, w1, w2) = prm
    mx = adaln(c, ada_w, ada_b)
    mc = adaln(c_ctx[None], ada_w, ada_b)
    hx = modulate(x, norm1, mx[0], mx[1]) @ w_in
    hc = modulate(ctx, norm1, mc[0], mc[1]) @ w_in
    att_x, att_c = gqa_mixer(hx, hc, q_norm, k_norm, ang, update_ctx)
    x = finish_sublayers(x, att_x, mx, w_out, norm2, w1, w2)
    if update_ctx:
        ctx = finish_sublayers(ctx, att_c, mc, w_out, norm2, w1, w2)
    return x, ctx


def setup_inputs(seed: int = 0) -> dict:
    key = jax.random.key(seed)
    ks = iter(jax.random.split(key, 40))

    def nrm(shape, s):
        return jax.random.normal(next(ks), shape, jnp.float32) * s

    def gain(n):
        return 1.0 + nrm((n,), 0.01)

    D = D_MODEL
    f_bias = jnp.linspace(ML_F_BIAS_LO, ML_F_BIAS_HI, ML_HEADS, dtype=jnp.float32)
    gate_b = nrm((2, 2, ML_HEADS), 0.01).at[:, 1].add(f_bias).reshape(-1)
    return {
        'x': nrm((BATCH, SEQ, D), 1.0),
        'c': nrm((BATCH, D), 1.0),
        'ctx': nrm((BATCH, CTX_LEN, D), 1.0),
        'c_ctx': nrm((D,), 1.0),
        'l0_ada_w': nrm((D, N_MOD * D), 0.5 * D ** -0.5),
        'l0_ada_b': nrm((N_MOD * D,), 0.01),
        'l0_norm1': gain(D),
        'l0_w_in': nrm((D, EVEN_IN), D ** -0.5),
        'l0_mla_q_norm': gain(MLA_Q_RANK),
        'l0_mla_w_uq': nrm((MLA_Q_RANK, MLA_HEADS * (MLA_NOPE + MLA_ROPE)), MLA_Q_RANK ** -0.5),
        'l0_mla_kv_norm': gain(MLA_KV_RANK),
        'l0_mla_w_ukv': nrm((MLA_KV_RANK, MLA_HEADS * (MLA_NOPE + MLA_V)), MLA_KV_RANK ** -0.5),
        'l0_ml_conv': nrm((ML_CONV, 2 * ML_HEADS * ML_DK), ML_CONV ** -0.5),
        'l0_ml_gate_b': gate_b,
        'l0_ml_head_norm': gain(ML_HEADS * ML_DV),
        'l0_w_out': nrm((EVEN_MIX, D), EVEN_MIX ** -0.5),
        'l0_norm2': gain(D),
        'l0_w1': nrm((D, D_FF), D ** -0.5),
        'l0_w2': nrm((D_FF, D), D_FF ** -0.5),
        'l1_ada_w': nrm((D, N_MOD * D), 0.5 * D ** -0.5),
        'l1_ada_b': nrm((N_MOD * D,), 0.01),
        'l1_norm1': gain(D),
        'l1_w_in': nrm((D, ODD_IN), D ** -0.5),
        'l1_q_norm': gain(GQA_DH),
        'l1_k_norm': gain(GQA_DH),
        'l1_w_out': nrm((ODD_MIX, D), ODD_MIX ** -0.5),
        'l1_norm2': gain(D),
        'l1_w1': nrm((D, D_FF), D ** -0.5),
        'l1_w2': nrm((D_FF, D), D_FF ** -0.5),
        'final_norm': gain(D),
    }


def reference(x, c, ctx, c_ctx,
              l0_ada_w, l0_ada_b, l0_norm1, l0_w_in, l0_mla_q_norm, l0_mla_w_uq, l0_mla_kv_norm, l0_mla_w_ukv,
              l0_ml_conv, l0_ml_gate_b, l0_ml_head_norm, l0_w_out, l0_norm2, l0_w1, l0_w2,
              l1_ada_w, l1_ada_b, l1_norm1, l1_w_in, l1_q_norm, l1_k_norm, l1_w_out, l1_norm2, l1_w1, l1_w2,
              final_norm):
    T = x.shape[1]
    ang_mla = grid_angles(T, MLA_ROPE)
    ang_gqa = grid_angles(T, GQA_DH)
    layers = (
        (even_layer, (l0_ada_w, l0_ada_b, l0_norm1, l0_w_in, l0_mla_q_norm, l0_mla_w_uq, l0_mla_kv_norm, l0_mla_w_ukv,
                      l0_ml_conv, l0_ml_gate_b, l0_ml_head_norm, l0_w_out, l0_norm2, l0_w1, l0_w2), ang_mla),
        (odd_layer, (l1_ada_w, l1_ada_b, l1_norm1, l1_w_in, l1_q_norm, l1_k_norm, l1_w_out, l1_norm2, l1_w1, l1_w2), ang_gqa),
    )
    for i in range(DEPTH):
        layer_fn, prm, ang = layers[i]
        x, ctx = layer_fn(x, ctx, c, c_ctx, prm, ang, i < DEPTH - 1)
    return rms_norm(x, final_norm)
```

```cpp
#include <hip/hip_runtime.h>
#include <hip/hip_cooperative_groups.h>
#include <cstdio>
namespace cg = cooperative_groups;

#ifndef MEGA
#define MEGA 1
#endif

typedef unsigned short bf16_t;
using bf16x8 = __attribute__((ext_vector_type(8))) short;
using s16x4  = __attribute__((ext_vector_type(4))) short;
using f32x16 = __attribute__((ext_vector_type(16))) float;
using u32x4  = __attribute__((ext_vector_type(4))) unsigned;
using u32x2  = __attribute__((ext_vector_type(2))) unsigned;
#define LAS __attribute__((address_space(3)))
typedef LAS char* LP;

constexpr int DM = 1024, NB = 4, SEQ = 8192, CTXL = 256, TPB = SEQ + CTXL, R = NB * TPB, DFF = 4096;
constexpr int P0W = 2464;
constexpr int NTHREADS = 512;
constexpr int LDS_BYTES = 135168 + 256;
constexpr int NPHASE = 21;
constexpr float EPS = 1e-6f;

constexpr size_t al256(size_t x) { return (x + 255) / 256 * 256; }
constexpr size_t WS_WT0_IN  = 0;
constexpr size_t WS_WT0_UQ  = WS_WT0_IN  + al256((size_t)2560 * 1024 * 2);
constexpr size_t WS_WT0_UKV = WS_WT0_UQ  + al256((size_t)768 * 256 * 2);
constexpr size_t WS_WT0_OUT = WS_WT0_UKV + al256((size_t)1024 * 128 * 2);
constexpr size_t WS_WT0_W1  = WS_WT0_OUT + al256((size_t)1024 * 1024 * 2);
constexpr size_t WS_WT0_W2  = WS_WT0_W1  + al256((size_t)4096 * 1024 * 2);
constexpr size_t WS_WT1_IN  = WS_WT0_W2  + al256((size_t)1024 * 4096 * 2);
constexpr size_t WS_WT1_OUT = WS_WT1_IN  + al256((size_t)1536 * 1024 * 2);
constexpr size_t WS_WT1_W1  = WS_WT1_OUT + al256((size_t)1024 * 1024 * 2);
constexpr size_t WS_WT1_W2  = WS_WT1_W1  + al256((size_t)4096 * 1024 * 2);
constexpr size_t WS_MODS    = WS_WT1_W2  + al256((size_t)1024 * 4096 * 2);
constexpr size_t WS_PART    = WS_MODS    + al256((size_t)2 * 5 * 6144 * 4);
constexpr size_t WS_ROPEM   = WS_PART    + al256((size_t)2 * 32 * 5 * 6144 * 4);
constexpr size_t WS_ROPEG   = WS_ROPEM   + al256((size_t)128 * 8 * 8);
constexpr size_t WS_SCTX    = WS_ROPEG   + al256((size_t)128 * 32 * 8);
constexpr size_t WS_GATES   = WS_SCTX    + al256((size_t)NB * CTXL * DM * 4);
constexpr size_t WS_H       = WS_GATES   + al256((size_t)R * 16 * 4);
constexpr size_t WS_BIG     = WS_H       + al256((size_t)R * 1024 * 2);
constexpr size_t WS_P0      = WS_BIG;
constexpr size_t WS_KV      = WS_P0   + al256((size_t)R * P0W * 2);
constexpr size_t WS_QM      = WS_KV   + al256((size_t)R * 1024 * 2);
constexpr size_t WS_CQN     = WS_QM   + al256((size_t)R * 768 * 2);
constexpr size_t WS_CKVN    = WS_CQN  + al256((size_t)R * 256 * 2);
constexpr size_t WS_KPE     = WS_CKVN + al256((size_t)R * 128 * 2);
constexpr size_t WS_HF      = WS_KPE  + al256((size_t)R * 32 * 2);
constexpr size_t WS_HB      = WS_HF   + al256((size_t)R * 512 * 2);
constexpr size_t WS_SCAL    = WS_HB   + al256((size_t)R * 512 * 2);
constexpr size_t WS_DEC     = WS_SCAL + al256((size_t)32 * TPB * 16);
constexpr size_t WS_CTR     = WS_DEC  + al256((size_t)32 * 66 * 4);
constexpr size_t WS_BAR     = WS_CTR  + 256;
constexpr size_t WS_XBAR    = WS_BAR  + 256;
constexpr size_t WS_END0    = WS_XBAR + al256((size_t)3456 * 4);
constexpr size_t WS_U       = WS_BIG;
constexpr size_t WS_QKV1    = WS_BIG;
constexpr size_t WS_END1    = WS_U + al256((size_t)R * 4096 * 2);
constexpr size_t WS_NEED    = WS_END0 > WS_END1 ? WS_END0 : WS_END1;

struct Params {
  const float *x, *c, *ctx, *c_ctx;
  const float *ada_w[2], *ada_b[2], *norm1[2], *w_in[2], *w_out[2], *norm2[2], *w1[2], *w2[2];
  const float *mla_q_norm, *mla_w_uq, *mla_kv_norm, *mla_w_ukv, *ml_conv, *ml_gate_b, *ml_head_norm;
  const float *q_norm1, *k_norm1, *final_norm;
  float* out;
  char* ws;
};

__device__ __forceinline__ int my_tid() { int t = threadIdx.x; asm volatile("" : "+v"(t)); return t; }
__device__ __forceinline__ float bf2f(bf16_t b) { return __uint_as_float(((unsigned)b) << 16); }
__device__ __forceinline__ unsigned cvtpk(float lo, float hi) {
  unsigned r; asm volatile("v_cvt_pk_bf16_f32 %0, %1, %2" : "=v"(r) : "v"(lo), "v"(hi)); return r;
}
__device__ __forceinline__ bf16_t f2bf(float x) { return (bf16_t)(cvtpk(x, 0.f) & 0xffffu); }
__device__ __forceinline__ int crow(int r, int hi) { return (r & 3) + 8 * (r >> 2) + 4 * hi; }
__device__ __forceinline__ float wave_sum(float v) {
#pragma unroll
  for (int o = 32; o >= 1; o >>= 1) v += __shfl_xor(v, o);
  return v;
}
__device__ __forceinline__ float siluf(float v) { return v / (1.f + __expf(-v)); }
__device__ __forceinline__ float sigmoidf(float v) { return 1.f / (1.f + __expf(-v)); }

__device__ __forceinline__ const float* in_row(const Params& p, int r) {
  const int b = r / TPB, tt = r - b * TPB;
  return tt < CTXL ? p.ctx + ((size_t)b * CTXL + tt) * DM : p.x + ((size_t)b * SEQ + (tt - CTXL)) * DM;
}
__device__ __forceinline__ float* s_row(const Params& p, int r) {
  const int b = r / TPB, tt = r - b * TPB;
  return tt < CTXL ? (float*)(p.ws + WS_SCTX) + ((size_t)b * CTXL + tt) * DM : p.out + ((size_t)b * SEQ + (tt - CTXL)) * DM;
}
__device__ __forceinline__ int mod_idx(int r) { const int b = r / TPB, tt = r - b * TPB; return tt < CTXL ? 4 : b; }
__device__ __forceinline__ int tile_row_all(int mt) { return mt * 256; }
__device__ __forceinline__ int tile_row_x(int i) { return (i >> 5) * TPB + CTXL + (i & 31) * 256; }

template <class Epi>
__device__ __forceinline__ void gemm256(const bf16_t* __restrict__ A, int lda, const bf16_t* __restrict__ Bt, int ldb, int K,
                                        LP lds, const Epi& epi) {
  const int tid = my_tid(), wid = tid >> 6, lane = tid & 63, r32 = lane & 31, hi = lane >> 5, wr = wid >> 2, wc = wid & 3;
  f32x16 acc[4][2];
#pragma unroll
  for (int i = 0; i < 4; ++i)
#pragma unroll
    for (int j = 0; j < 2; ++j) acc[i][j] = f32x16{};
  const int srow = tid >> 3, cso = ((tid & 7) ^ ((tid >> 4) & 7)) * 8;
  const bf16_t* Ag = A + (size_t)srow * lda + cso;
  const bf16_t* Bg = Bt + (size_t)srow * ldb + cso;
  const int nk = K >> 6;
#define STAGE(buf, kt) do { _Pragma("unroll") for (int i_ = 0; i_ < 4; ++i_) { \
    __builtin_amdgcn_global_load_lds((const unsigned*)(Ag + (size_t)(i_ * 64) * lda + (kt) * 64), (LAS unsigned*)(lds + (buf) * 65536 + (i_ * 512 + wid * 64) * 16), 16, 0, 0); \
    __builtin_amdgcn_global_load_lds((const unsigned*)(Bg + (size_t)(i_ * 64) * ldb + (kt) * 64), (LAS unsigned*)(lds + (buf) * 65536 + 32768 + (i_ * 512 + wid * 64) * 16), 16, 0, 0); } } while (0)
  const int swz = (r32 >> 1) & 7;
  const int aoff = (wr * 128 + r32) * 128, boff = 32768 + (wc * 64 + r32) * 128;
  __syncthreads();
  STAGE(0, 0);
  __syncthreads();
#define LOADF(F, G, kk) do { const int so_ = (((kk) * 2 + hi) ^ swz) << 4; \
    _Pragma("unroll") for (int i_ = 0; i_ < 4; ++i_) F[i_] = *reinterpret_cast<const LAS bf16x8*>(base + aoff + i_ * 4096 + so_); \
    _Pragma("unroll") for (int j_ = 0; j_ < 2; ++j_) G[j_] = *reinterpret_cast<const LAS bf16x8*>(base + boff + j_ * 4096 + so_); } while (0)
#define MMA(F, G) do { _Pragma("unroll") for (int i_ = 0; i_ < 4; ++i_) _Pragma("unroll") for (int j_ = 0; j_ < 2; ++j_) \
    acc[i_][j_] = __builtin_amdgcn_mfma_f32_32x32x16_bf16(F[i_], G[j_], acc[i_][j_], 0, 0, 0); } while (0)
  for (int kt = 0; kt < nk; ++kt) {
    if (kt + 1 < nk) STAGE((kt + 1) & 1, kt + 1);
    const LP base = lds + (kt & 1) * 65536;
    bf16x8 a0[4], b0[2], a1[4], b1[2];
    LOADF(a0, b0, 0); __builtin_amdgcn_sched_barrier(0);
    LOADF(a1, b1, 1); MMA(a0, b0); __builtin_amdgcn_sched_barrier(0);
    LOADF(a0, b0, 2); MMA(a1, b1); __builtin_amdgcn_sched_barrier(0);
    LOADF(a1, b1, 3); MMA(a0, b0); __builtin_amdgcn_sched_barrier(0);
    MMA(a1, b1);
    __syncthreads();
  }
#undef LOADF
#undef MMA
#undef STAGE
  int e_rr = wr * 128, e_cc = wc * 64 + r32, e_hi = hi;
  asm volatile("" : "+v"(e_rr), "+v"(e_cc), "+v"(e_hi));
#pragma unroll
  for (int i = 0; i < 4; ++i)
#pragma unroll
    for (int j = 0; j < 2; ++j) { __builtin_amdgcn_sched_barrier(0); epi(e_rr + i * 32, e_cc + j * 32, e_hi, acc[i][j]); }
  __builtin_amdgcn_sched_barrier(0);
}

template <class Epi>
__device__ __forceinline__ void gemm8p(const bf16_t* __restrict__ A, int lda, const bf16_t* __restrict__ Bt, int ldb, int K,
                                       LP lds, const Epi& epi, bool pre = false, const bf16_t* An = nullptr, const bf16_t* Bn = nullptr) {
  const int tid = my_tid(), wid = tid >> 6, lane = tid & 63, r32 = lane & 31, hi = lane >> 5, wr = wid >> 2, wc = wid & 3;
  f32x16 acc[2][2][2];
#pragma unroll
  for (int a = 0; a < 2; ++a)
#pragma unroll
    for (int b = 0; b < 2; ++b) { acc[a][b][0] = f32x16{}; acc[a][b][1] = f32x16{}; }
  bf16x8 At[2][4], B0[4], B1[4];
  const int srow = tid >> 3, cso = ((tid & 7) ^ ((tid >> 4) & 7)) * 8;
  const bf16_t* Ag = A + (size_t)srow * lda + cso;
  const bf16_t* Bg = Bt + (size_t)srow * ldb + cso;
  const int swz = (r32 >> 1) & 7;
  const LP la = lds + (wr * 64 + r32) * 128, lb = lds + 65536 + (wc * 32 + r32) * 128;
  const LP lw = lds + wid * 1024;
#define G8_SA(b, h) (((b) * 2 + (h)) * 16384)
#define G8_SB(b, h) (65536 + ((b) * 2 + (h)) * 16384)
#define G8_STAGE(P, G, ld, h, kt) do { _Pragma("unroll") for (int i_ = 0; i_ < 2; ++i_) \
    __builtin_amdgcn_global_load_lds((const unsigned*)(G + (size_t)((h) * 128 + i_ * 64) * (ld) + (size_t)(kt) * 64), (LAS unsigned*)(lw + (P) + i_ * 8192), 16, 0, 0); } while (0)
#define G8_STA(b, h, kt) G8_STAGE(G8_SA(b, h), Ag, lda, h, kt)
#define G8_STB(b, h, kt) G8_STAGE(G8_SB(b, h), Bg, ldb, h, kt)
#define G8_LDA(b, h) do { _Pragma("unroll") for (int m_ = 0; m_ < 2; ++m_) _Pragma("unroll") for (int k_ = 0; k_ < 4; ++k_) \
    At[m_][k_] = *reinterpret_cast<const LAS bf16x8*>(la + ((b) * 2 + (h)) * 16384 + m_ * 4096 + (((k_ * 2 + hi) ^ swz) << 4)); } while (0)
#define G8_LDB(dst, b, h) do { _Pragma("unroll") for (int k_ = 0; k_ < 4; ++k_) \
    dst[k_] = *reinterpret_cast<const LAS bf16x8*>(lb + ((b) * 2 + (h)) * 16384 + (((k_ * 2 + hi) ^ swz) << 4)); } while (0)
#define G8_MMA(ai, bj, Bx) do { __builtin_amdgcn_s_setprio(1); _Pragma("unroll") for (int k_ = 0; k_ < 4; ++k_) _Pragma("unroll") for (int m_ = 0; m_ < 2; ++m_) \
    acc[ai][bj][m_] = __builtin_amdgcn_mfma_f32_32x32x16_bf16(At[m_][k_], Bx[k_], acc[ai][bj][m_], 0, 0, 0); __builtin_amdgcn_s_setprio(0); } while (0)
#define G8_WV(n) asm volatile("s_waitcnt vmcnt(" #n ")" ::: "memory")
#define G8_WL(n) asm volatile("s_waitcnt lgkmcnt(" #n ")" ::: "memory")
#define G8_BAR __builtin_amdgcn_s_barrier()
#define G8_SCHED __builtin_amdgcn_sched_barrier(0)
  const int nt = K >> 6;
  __syncthreads();
  G8_SCHED;
  if (!pre) { G8_STB(0, 0, 0); G8_STA(0, 0, 0); G8_STB(0, 1, 0); G8_STA(0, 1, 0); }
  if (wr == 1) G8_BAR;
  G8_WV(4); G8_BAR;
  G8_STB(1, 0, 1); G8_STA(1, 0, 1); G8_STB(1, 1, 1);
  G8_WV(6); G8_BAR;
  G8_SCHED;
  for (int t = 0; t < nt - 2; t += 2) {
    G8_LDB(B0, 0, 0); G8_SCHED; G8_LDA(0, 0); G8_STA(1, 1, t + 1);
    G8_WL(8); G8_BAR; G8_WL(0); G8_MMA(0, 0, B0); G8_BAR; G8_SCHED;
    G8_LDB(B1, 0, 1); G8_STB(0, 0, t + 2);
    G8_BAR; G8_WL(0); G8_MMA(0, 1, B1); G8_BAR; G8_SCHED;
    G8_LDA(0, 1); G8_STA(0, 0, t + 2);
    G8_BAR; G8_WL(0); G8_MMA(1, 0, B0); G8_BAR; G8_SCHED;
    G8_STB(0, 1, t + 2);
    G8_WV(6); G8_BAR; G8_MMA(1, 1, B1); G8_BAR; G8_SCHED;
    G8_LDB(B0, 1, 0); G8_SCHED; G8_LDA(1, 0); G8_STA(0, 1, t + 2);
    G8_WL(8); G8_BAR; G8_WL(0); G8_MMA(0, 0, B0); G8_BAR; G8_SCHED;
    G8_LDB(B1, 1, 1); G8_STB(1, 0, t + 3);
    G8_BAR; G8_WL(0); G8_MMA(0, 1, B1); G8_BAR; G8_SCHED;
    G8_LDA(1, 1); G8_STA(1, 0, t + 3);
    G8_BAR; G8_WL(0); G8_MMA(1, 0, B0); G8_BAR; G8_SCHED;
    G8_STB(1, 1, t + 3);
    G8_WV(6); G8_BAR; G8_MMA(1, 1, B1); G8_BAR; G8_SCHED;
  }
  { G8_LDB(B0, 0, 0); G8_LDA(0, 0); G8_STA(1, 1, nt - 1);
    G8_BAR; G8_WL(0); G8_MMA(0, 0, B0); G8_BAR; G8_SCHED;
    G8_LDB(B1, 0, 1); G8_BAR; G8_WL(0); G8_MMA(0, 1, B1); G8_BAR; G8_SCHED;
    G8_LDA(0, 1); G8_WV(4); G8_BAR; G8_WL(0); G8_MMA(1, 0, B0); G8_MMA(1, 1, B1); G8_BAR; G8_SCHED; }
  { G8_LDB(B0, 1, 0); G8_LDA(1, 0); G8_WV(2); G8_BAR; G8_WL(0); G8_MMA(0, 0, B0); G8_BAR; G8_SCHED;
    G8_LDB(B1, 1, 1); G8_WV(0); G8_BAR; G8_WL(0); G8_MMA(0, 1, B1); G8_BAR; G8_SCHED;
    G8_LDA(1, 1); G8_BAR; G8_WL(0); G8_MMA(1, 0, B0); G8_MMA(1, 1, B1); G8_BAR; G8_SCHED; }
  if (wr == 0) G8_BAR;
  G8_SCHED;
  if (An != nullptr) {
    const bf16_t* Ag2 = An + (size_t)srow * lda + cso; const bf16_t* Bg2 = Bn + (size_t)srow * ldb + cso;
    G8_STAGE(G8_SB(0, 0), Bg2, ldb, 0, 0); G8_STAGE(G8_SA(0, 0), Ag2, lda, 0, 0); G8_STAGE(G8_SB(0, 1), Bg2, ldb, 1, 0); G8_STAGE(G8_SA(0, 1), Ag2, lda, 1, 0);
  }
  G8_SCHED;
#undef G8_SA
#undef G8_SB
#undef G8_STAGE
#undef G8_STA
#undef G8_STB
#undef G8_LDA
#undef G8_LDB
#undef G8_MMA
#undef G8_WV
#undef G8_WL
#undef G8_BAR
#undef G8_SCHED
  int e_rr = wr * 64, e_cc = wc * 32 + r32, e_hi = hi;
  asm volatile("" : "+v"(e_rr), "+v"(e_cc), "+v"(e_hi));
#pragma unroll
  for (int a = 0; a < 2; ++a)
#pragma unroll
    for (int b = 0; b < 2; ++b)
#pragma unroll
      for (int m = 0; m < 2; ++m) { __builtin_amdgcn_sched_barrier(0); epi(a * 128 + e_rr + m * 32, b * 128 + e_cc, e_hi, acc[a][b][m]); }
  __builtin_amdgcn_sched_barrier(0);
}

#define KSWZ(row, colB) ((row) * 256 + ((colB) ^ (((row) & 7) << 4)))
#define SBAR() __builtin_amdgcn_sched_barrier(0)
constexpr int SHM_V = 64 * 128 * 2, SHM_K = 64 * 128 * 2;

__device__ __forceinline__ void partialSM(f32x16& p0, f32x16& p1, float& m_reg, float& mn, float& alpha, float C, float thr) {
  float pmax = p0[0];
#pragma unroll
  for (int r = 1; r < 16; ++r) pmax = fmaxf(pmax, p0[r]);
#pragma unroll
  for (int r = 0; r < 16; ++r) pmax = fmaxf(pmax, p1[r]);
  { auto rr = __builtin_amdgcn_permlane32_swap(__float_as_uint(pmax), __float_as_uint(pmax), false, false);
    pmax = fmaxf(__uint_as_float(rr[0]), __uint_as_float(rr[1])); }
  if (__builtin_expect(__all(pmax - m_reg <= thr), 1)) { mn = m_reg; alpha = 1.f; }
  else { mn = fmaxf(m_reg, pmax); alpha = __builtin_amdgcn_exp2f((m_reg - mn) * C); m_reg = mn; }
  const float mnC = -mn * C;
#pragma unroll
  for (int r = 0; r < 16; ++r) p0[r] = fmaf(p0[r], C, mnC);
#pragma unroll
  for (int r = 0; r < 16; ++r) p1[r] = fmaf(p1[r], C, mnC);
#pragma unroll
  for (int r = 0; r < 16; ++r) p0[r] = __builtin_amdgcn_exp2f(p0[r]);
}
__device__ __forceinline__ void finishSM(f32x16& p0, f32x16& p1, float alpha, float& l_reg, bf16x8& pa0, bf16x8& pa1, bf16x8& pa2, bf16x8& pa3) {
#pragma unroll
  for (int r = 0; r < 16; ++r) p1[r] = __builtin_amdgcn_exp2f(p1[r]);
  float ps = 0;
#pragma unroll
  for (int r = 0; r < 16; ++r) ps += p0[r];
#pragma unroll
  for (int r = 0; r < 16; ++r) ps += p1[r];
  { auto rr = __builtin_amdgcn_permlane32_swap(__float_as_uint(ps), __float_as_uint(ps), false, false);
    ps = __uint_as_float(rr[0]) + __uint_as_float(rr[1]); }
  l_reg = l_reg * alpha + ps;
#define PK4(P, BASE, OUT) do { unsigned a0 = cvtpk(P[BASE + 0], P[BASE + 1]), a1 = cvtpk(P[BASE + 2], P[BASE + 3]);   \
    unsigned b0 = cvtpk(P[BASE + 4], P[BASE + 5]), b1 = cvtpk(P[BASE + 6], P[BASE + 7]);                              \
    auto r0 = __builtin_amdgcn_permlane32_swap(a0, b0, false, false); auto r1 = __builtin_amdgcn_permlane32_swap(a1, b1, false, false); \
    u32x4 w = {r0[0], r1[0], r0[1], r1[1]}; OUT = *reinterpret_cast<bf16x8*>(&w); } while (0)
  PK4(p0, 0, pa0); PK4(p0, 8, pa1); PK4(p1, 0, pa2); PK4(p1, 8, pa3);
#undef PK4
}
template <int NDQ>
__device__ __forceinline__ void qkt(f32x16& p0, f32x16& p1, const LAS char* Ks, const bf16x8* qr, int r32, int hi) {
  p0 = f32x16{}; p1 = f32x16{};
#pragma unroll
  for (int d0 = 0; d0 < NDQ; ++d0) { const int cb = (d0 * 16 + hi * 8) * 2;
    bf16x8 b0 = *reinterpret_cast<const LAS bf16x8*>(Ks + KSWZ(r32, cb));
    bf16x8 b1 = *reinterpret_cast<const LAS bf16x8*>(Ks + KSWZ(32 + r32, cb));
    p0 = __builtin_amdgcn_mfma_f32_32x32x16_bf16(b0, qr[d0], p0, 0, 0, 0);
    p1 = __builtin_amdgcn_mfma_f32_32x32x16_bf16(b1, qr[d0], p1, 0, 0, 0); }
}
__device__ __forceinline__ int v_st(int k, int c) { const int kk = (k & ~0xC) | ((k & 4) << 1) | ((k & 8) >> 1); return ((kk >> 3) * 4 + (c >> 5)) * 512 + ((kk & 7) * 32 + (c & 31)) * 2; }
__device__ __forceinline__ int v_rd_base(int lane) { return ((lane & 3) << 3) | (((lane >> 2) & 3) << 6) | (((lane >> 4) & 1) << 5) | (((lane >> 5) & 1) << 8); }
constexpr int v_rd_off(int d0, int ks, int half) { return d0 * 512 + ks * 4096 + half * 2048; }
template <int OFF> __device__ __forceinline__ s16x4 tr_read(int vb) {
  s16x4 r; asm volatile("ds_read_b64_tr_b16 %0, %1 offset:%2" : "=&v"(r) : "v"(vb), "i"(OFF) : "memory"); return r;
}
template <int D0> __device__ __forceinline__ void pv_one(f32x16& od, int vb, bf16x8 pa0, bf16x8 pa1, bf16x8 pa2, bf16x8 pa3) {
  const s16x4 l0 = tr_read<v_rd_off(D0, 0, 0)>(vb), h0 = tr_read<v_rd_off(D0, 0, 1)>(vb), l1 = tr_read<v_rd_off(D0, 1, 0)>(vb), h1 = tr_read<v_rd_off(D0, 1, 1)>(vb);
  const s16x4 l2 = tr_read<v_rd_off(D0, 2, 0)>(vb), h2 = tr_read<v_rd_off(D0, 2, 1)>(vb), l3 = tr_read<v_rd_off(D0, 3, 0)>(vb), h3 = tr_read<v_rd_off(D0, 3, 1)>(vb);
  asm volatile("s_waitcnt lgkmcnt(0)" ::: "memory"); SBAR();
#define PK(L, H) (bf16x8){L[0], L[1], L[2], L[3], H[0], H[1], H[2], H[3]}
  od = __builtin_amdgcn_mfma_f32_32x32x16_bf16(pa0, PK(l0, h0), od, 0, 0, 0);
  od = __builtin_amdgcn_mfma_f32_32x32x16_bf16(pa1, PK(l1, h1), od, 0, 0, 0);
  od = __builtin_amdgcn_mfma_f32_32x32x16_bf16(pa2, PK(l2, h2), od, 0, 0, 0);
  od = __builtin_amdgcn_mfma_f32_32x32x16_bf16(pa3, PK(l3, h3), od, 0, 0, 0);
#undef PK
}
template <int NDV>
__device__ __forceinline__ void pv_d0(f32x16* o, int vb, bf16x8 pa0, bf16x8 pa1, bf16x8 pa2, bf16x8 pa3) {
  pv_one<0>(o[0], vb, pa0, pa1, pa2, pa3); pv_one<1>(o[1], vb, pa0, pa1, pa2, pa3);
  if constexpr (NDV == 4) { pv_one<2>(o[2], vb, pa0, pa1, pa2, pa3); pv_one<3>(o[3], vb, pa0, pa1, pa2, pa3); }
}

template <int NDQ, int NDV>
__device__ __forceinline__ void attn_body(const bf16_t* __restrict__ Qb, int ldq, const bf16_t* __restrict__ kptr, int kstr,
                                          const bf16_t* __restrict__ vptr, int vstr, bf16_t* __restrict__ Ob, int ldo, int seq,
                                          float Cs, float thr, LP lds) {
  const int tid = my_tid(), wid = tid >> 6, lane = tid & 63, r32 = lane & 31, hi = lane >> 5;
  LP V_lds = lds; LP K_lds = lds + 2 * SHM_V;
  LAS float* wsx = (LAS float*)(lds + 2 * SHM_V + 2 * SHM_K) + wid * 64; LAS float* li_l = wsx; LAS float* al_l = wsx + 32;
  float m_reg = -1e30f, l_reg = 0; f32x16 o[NDV]; bf16x8 qr[NDQ];
#pragma unroll
  for (int d = 0; d < NDV; ++d) o[d] = f32x16{};
  const bf16_t* Qw = Qb + (size_t)(wid * 32 + r32) * ldq + hi * 8;
#pragma unroll
  for (int d0 = 0; d0 < NDQ; ++d0) qr[d0] = *reinterpret_cast<const bf16x8*>(Qw + d0 * 16);
  const int sr = tid >> 4, sc = (tid & 15) * 8, vst0 = v_st(sr, sc), vst1 = v_st(32 + sr, sc);
  const int vb0 = (int)(unsigned)(size_t)V_lds + v_rd_base(lane);
  struct { bf16x8 vs0, vs1, ks0, ks1; } sr_[2];
#define SLOAD(i, k0) do { sr_[i].vs0 = *reinterpret_cast<const bf16x8*>(vptr + (size_t)((k0) + sr) * vstr); \
    sr_[i].vs1 = *reinterpret_cast<const bf16x8*>(vptr + (size_t)((k0) + 32 + sr) * vstr); \
    sr_[i].ks0 = *reinterpret_cast<const bf16x8*>(kptr + (size_t)((k0) + sr) * kstr); \
    sr_[i].ks1 = *reinterpret_cast<const bf16x8*>(kptr + (size_t)((k0) + 32 + sr) * kstr); } while (0)
#define SWRITE(b, i) do { *(LAS bf16x8*)(V_lds + (b) * SHM_V + vst0) = sr_[i].vs0;          \
    *(LAS bf16x8*)(V_lds + (b) * SHM_V + vst1) = sr_[i].vs1; const int kc = sc * 2;               \
    *(LAS bf16x8*)(K_lds + (b) * SHM_K + KSWZ(sr, kc)) = sr_[i].ks0;                       \
    *(LAS bf16x8*)(K_lds + (b) * SHM_K + KSWZ(32 + sr, kc)) = sr_[i].ks1; } while (0)
#define SWAIT() asm volatile("s_waitcnt vmcnt(4)" ::: "memory")
#define RESC(a) do { if (__any((a) < 1.f)) { if (hi == 0) al_l[r32] = (a); asm volatile("s_waitcnt lgkmcnt(0)" ::: "memory"); \
    _Pragma("unroll") for (int d = 0; d < NDV; ++d) _Pragma("unroll") for (int r = 0; r < 16; ++r) o[d][r] *= al_l[crow(r, hi)]; } } while (0)
  f32x16 pA0, pA1, pB0, pB1; float mnA, mnB, alA, alB; bf16x8 pa0, pa1, pa2, pa3; const int NT = seq / 64;
  constexpr int SE = 0, SO = 1;
  __syncthreads();
  SLOAD(SE, 0); asm volatile("s_waitcnt vmcnt(0)" ::: "memory"); SWRITE(0, SE); __syncthreads();
  qkt<NDQ>(pA0, pA1, K_lds, qr, r32, hi); partialSM(pA0, pA1, m_reg, mnA, alA, Cs, thr);
  SLOAD(SO, 64); if (2 < NT) SLOAD(SE, 128);
  SWAIT(); SWRITE(1, SO); __syncthreads();
  for (int j = 1; j + 1 < NT; j += 2) {
    SBAR(); qkt<NDQ>(pB0, pB1, K_lds + SHM_K, qr, r32, hi);
    finishSM(pA0, pA1, alA, l_reg, pa0, pa1, pa2, pa3); SBAR();
    SLOAD(SO, (j + 2) * 64); SBAR();
    pv_d0<NDV>(o, vb0, pa0, pa1, pa2, pa3); partialSM(pB0, pB1, m_reg, mnB, alB, Cs, thr);
    __syncthreads(); SWAIT(); SWRITE(0, SE);
    RESC(alB); __syncthreads();
    SBAR(); qkt<NDQ>(pA0, pA1, K_lds, qr, r32, hi);
    finishSM(pB0, pB1, alB, l_reg, pa0, pa1, pa2, pa3); SBAR();
    if (j + 3 < NT) SLOAD(SE, (j + 3) * 64); SBAR();
    pv_d0<NDV>(o, vb0 + SHM_V, pa0, pa1, pa2, pa3); partialSM(pA0, pA1, m_reg, mnA, alA, Cs, thr);
    __syncthreads(); SWAIT(); SWRITE(1, SO);
    RESC(alA); __syncthreads();
  }
  SBAR(); qkt<NDQ>(pB0, pB1, K_lds + SHM_K, qr, r32, hi);
  finishSM(pA0, pA1, alA, l_reg, pa0, pa1, pa2, pa3); SBAR();
  pv_d0<NDV>(o, vb0, pa0, pa1, pa2, pa3); partialSM(pB0, pB1, m_reg, mnB, alB, Cs, thr);
  __syncthreads(); RESC(alB);
  finishSM(pB0, pB1, alB, l_reg, pa0, pa1, pa2, pa3); SBAR();
  pv_d0<NDV>(o, vb0 + SHM_V, pa0, pa1, pa2, pa3);
  if (hi == 0) li_l[r32] = l_reg; asm volatile("s_waitcnt lgkmcnt(0)" ::: "memory");
  float rli[16];
#pragma unroll
  for (int r = 0; r < 16; ++r) rli[r] = __builtin_amdgcn_rcpf(li_l[crow(r, hi)]);
  bf16_t* Ow = Ob + (size_t)(wid * 32) * ldo;
#pragma unroll
  for (int r = 0; r < 16; ++r) { const int orow = crow(r, hi);
#pragma unroll
    for (int d0 = 0; d0 < NDV; ++d0) Ow[(size_t)orow * ldo + d0 * 32 + r32] = f2bf(o[d0][r] * rli[r]); }
#undef SLOAD
#undef SWRITE
#undef SWAIT
#undef RESC
}

__device__ __forceinline__ void convert_T(const float* __restrict__ W, int K, int N, int Npad, bf16_t* __restrict__ WT, LP lds) {
  LAS float* tile = (LAS float*)lds;
  const int tid = my_tid();
  const int tn = Npad / 64, ntile = (K / 64) * tn;
  for (int t = blockIdx.x; t < ntile; t += gridDim.x) {
    const int k0 = (t / tn) * 64, n0 = (t % tn) * 64;
    __syncthreads();
    { const int kr = tid >> 4, nc = (tid & 15) * 4;
#pragma unroll
      for (int i = 0; i < 2; ++i) {
        float4 v = make_float4(0.f, 0.f, 0.f, 0.f);
        if (n0 + nc < N) v = *reinterpret_cast<const float4*>(W + (size_t)(k0 + kr + i * 32) * N + n0 + nc);
        LAS float* d = tile + (kr + i * 32) * 65 + nc; d[0] = v.x; d[1] = v.y; d[2] = v.z; d[3] = v.w;
      } }
    __syncthreads();
    { const int nr = tid >> 3, kc = (tid & 7) * 8;
      u32x4 w;
      w[0] = cvtpk(tile[(kc + 0) * 65 + nr], tile[(kc + 1) * 65 + nr]); w[1] = cvtpk(tile[(kc + 2) * 65 + nr], tile[(kc + 3) * 65 + nr]);
      w[2] = cvtpk(tile[(kc + 4) * 65 + nr], tile[(kc + 5) * 65 + nr]); w[3] = cvtpk(tile[(kc + 6) * 65 + nr], tile[(kc + 7) * 65 + nr]);
      *reinterpret_cast<u32x4*>(WT + (size_t)(n0 + nr) * K + k0 + kc) = w; }
  }
}
__device__ __forceinline__ void phase_prep(const Params& p, LP lds) {
  char* ws = p.ws;
  convert_T(p.w_in[0], 1024, 2480, 2560, (bf16_t*)(ws + WS_WT0_IN), lds);
  convert_T(p.mla_w_uq, 256, 768, 768, (bf16_t*)(ws + WS_WT0_UQ), lds);
  convert_T(p.mla_w_ukv, 128, 1024, 1024, (bf16_t*)(ws + WS_WT0_UKV), lds);
  convert_T(p.w_out[0], 1024, 1024, 1024, (bf16_t*)(ws + WS_WT0_OUT), lds);
  convert_T(p.w1[0], 1024, 4096, 4096, (bf16_t*)(ws + WS_WT0_W1), lds);
  convert_T(p.w2[0], 4096, 1024, 1024, (bf16_t*)(ws + WS_WT0_W2), lds);
  convert_T(p.w_in[1], 1024, 1536, 1536, (bf16_t*)(ws + WS_WT1_IN), lds);
  convert_T(p.w_out[1], 1024, 1024, 1024, (bf16_t*)(ws + WS_WT1_OUT), lds);
  convert_T(p.w1[1], 1024, 4096, 4096, (bf16_t*)(ws + WS_WT1_W1), lds);
  convert_T(p.w2[1], 4096, 1024, 1024, (bf16_t*)(ws + WS_WT1_W2), lds);
  if (blockIdx.x == 0 && my_tid() < 64) ((int*)(ws + WS_CTR))[my_tid()] = 0;
  LAS float* sc = (LAS float*)lds; const int tid = my_tid();
  float* part = (float*)(ws + WS_PART);
  for (int it = blockIdx.x; it < 192; it += gridDim.x) {
    const int L = it / 96, rem = it % 96, ks = rem / 3, ch = rem % 3, k0 = ks * 32;
    __syncthreads();
    if (tid < 160) { const int mb = tid >> 5, kk = tid & 31; const float v = mb < 4 ? p.c[mb * 1024 + k0 + kk] : p.c_ctx[k0 + kk]; sc[tid] = v / (1.f + expf(-v)); }
    __syncthreads();
    const int n = ch * 2048 + tid * 4;
    float4 acc[5];
#pragma unroll
    for (int mb = 0; mb < 5; ++mb) acc[mb] = make_float4(0.f, 0.f, 0.f, 0.f);
    const float* wp = p.ada_w[L] + (size_t)k0 * 6144 + n;
    for (int kk = 0; kk < 32; ++kk) {
      const float4 w = *reinterpret_cast<const float4*>(wp + (size_t)kk * 6144);
#pragma unroll
      for (int mb = 0; mb < 5; ++mb) { const float s = sc[mb * 32 + kk]; acc[mb].x += s * w.x; acc[mb].y += s * w.y; acc[mb].z += s * w.z; acc[mb].w += s * w.w; }
    }
#pragma unroll
    for (int mb = 0; mb < 5; ++mb) *reinterpret_cast<float4*>(part + ((size_t)((L * 32 + ks) * 5 + mb)) * 6144 + n) = acc[mb];
  }
}
__device__ __forceinline__ void phase_mods(const Params& p) {
  char* ws = p.ws; const float* part = (const float*)(ws + WS_PART); float* mods = (float*)(ws + WS_MODS);
  const int gt = blockIdx.x * NTHREADS + my_tid(), gs = gridDim.x * NTHREADS;
  for (int i = gt; i < 2 * 5 * 6144; i += gs) {
    const int L = i / 30720, rem = i % 30720, mb = rem / 6144, n = rem % 6144;
    float s = p.ada_b[L][n];
    for (int ks = 0; ks < 32; ++ks) s += part[((size_t)((L * 32 + ks) * 5 + mb)) * 6144 + n];
    mods[i] = s;
  }
  float2* rm = (float2*)(ws + WS_ROPEM); float2* rg = (float2*)(ws + WS_ROPEG);
  for (int i = gt; i < 128 * 8 + 128 * 32; i += gs) {
    if (i < 1024) { const int pos = i >> 3, f = i & 7; const float fr = powf(10000.f, -(float)f / 8.f); const float a = (float)pos * fr; rm[i] = make_float2(cosf(a), sinf(a)); }
    else { const int k = i - 1024, pos = k >> 5, f = k & 31; const float fr = powf(10000.f, -(float)f / 32.f); const float a = (float)pos * fr; rg[k] = make_float2(cosf(a), sinf(a)); }
  }
}
__device__ __forceinline__ void phase_norm(const Params& p, int L, int which, const float* __restrict__ gain, int shift_slot, bool xonly) {
  const int lane = my_tid() & 63, gw = blockIdx.x * 8 + (my_tid() >> 6), nw = gridDim.x * 8;
  const float* mods = (const float*)(p.ws + WS_MODS) + (size_t)L * 5 * 6144;
  bf16_t* H = (bf16_t*)(p.ws + WS_H);
  float4 v[4];
  auto row_ok = [&](int r) __attribute__((always_inline)) -> bool { if (r >= R) return false; const int tt = r % TPB; return !(xonly && tt < CTXL); };
  auto row_load = [&](int r, float4* d) __attribute__((always_inline)) { const float* src = which == 0 ? in_row(p, r) : s_row(p, r);
#pragma unroll
    for (int i = 0; i < 4; ++i) d[i] = *reinterpret_cast<const float4*>(src + i * 256 + lane * 4); };
  if (row_ok(gw)) row_load(gw, v);
  for (int r = gw; r < R; r += nw) {
    const int rn = r + nw; const bool okn = row_ok(rn);
    float4 vn[4];
#pragma unroll
    for (int i = 0; i < 4; ++i) vn[i] = make_float4(0.f, 0.f, 0.f, 0.f);
    if (okn) row_load(rn, vn);
    if (row_ok(r)) {
      const int b = r / TPB, tt = r - b * TPB;
      const float* md = mods + (size_t)(tt < CTXL ? 4 : b) * 6144;
      float ss = 0;
#pragma unroll
      for (int i = 0; i < 4; ++i) ss += v[i].x * v[i].x + v[i].y * v[i].y + v[i].z * v[i].z + v[i].w * v[i].w;
      ss = wave_sum(ss);
      if (which == 0 && tt < CTXL) { float* sd = s_row(p, r);
#pragma unroll
        for (int i = 0; i < 4; ++i) *reinterpret_cast<float4*>(sd + i * 256 + lane * 4) = v[i]; }
      const float rstd = rsqrtf(ss * (1.f / 1024.f) + EPS);
#pragma unroll
      for (int i = 0; i < 4; ++i) {
        const int c = i * 256 + lane * 4;
        const float4 g = *reinterpret_cast<const float4*>(gain + c);
        const float4 sh = *reinterpret_cast<const float4*>(md + shift_slot * 1024 + c);
        const float4 scl = *reinterpret_cast<const float4*>(md + (shift_slot + 1) * 1024 + c);
        const float o0 = v[i].x * rstd * g.x * (1.f + scl.x) + sh.x, o1 = v[i].y * rstd * g.y * (1.f + scl.y) + sh.y;
        const float o2 = v[i].z * rstd * g.z * (1.f + scl.z) + sh.z, o3 = v[i].w * rstd * g.w * (1.f + scl.w) + sh.w;
        u32x2 w = {cvtpk(o0, o1), cvtpk(o2, o3)};
        *reinterpret_cast<u32x2*>(H + (size_t)r * 1024 + c) = w;
      }
    }
#pragma unroll
    for (int i = 0; i < 4; ++i) v[i] = vn[i];
  }
}
__device__ __forceinline__ void mlstm_scal(const Params& p, int chain, LP lds);
__device__ __forceinline__ void phase_prep0(const Params& p, LP lds) {
  if (blockIdx.x < 32) { mlstm_scal(p, blockIdx.x, lds); return; }
  const int lane = my_tid() & 63, gw = (blockIdx.x - 32) * 8 + (my_tid() >> 6), nw = (gridDim.x - 32) * 8;
  const bf16_t* P0 = (const bf16_t*)(p.ws + WS_P0);
  bf16_t* CQN = (bf16_t*)(p.ws + WS_CQN); bf16_t* CKVN = (bf16_t*)(p.ws + WS_CKVN); bf16_t* KPE = (bf16_t*)(p.ws + WS_KPE);
  const float2* rm = (const float2*)(p.ws + WS_ROPEM);
  bf16_t* MQ = (bf16_t*)p.out; bf16_t* MK = MQ + (size_t)R * 512;
  for (int r = gw; r < R; r += nw) {
    const int b = r / TPB, tt = r - b * TPB;
    const bf16_t* row = P0 + (size_t)r * P0W;
    {
      const int lo = tt < CTXL ? 0 : CTXL, hi_ = tt < CTXL ? CTXL : TPB;
      float aq[8], ak[8];
#pragma unroll
      for (int i = 0; i < 8; ++i) { aq[i] = 0.f; ak[i] = 0.f; }
#pragma unroll
      for (int kk = 0; kk < 3; ++kk) { const int t2 = tt + kk - 1;
        if (t2 >= lo && t2 < hi_) { const bf16_t* r2 = P0 + (size_t)(r + kk - 1) * P0W + 416 + lane * 8;
          const u32x4 qv = *reinterpret_cast<const u32x4*>(r2), kv = *reinterpret_cast<const u32x4*>(r2 + 512);
          const float* wq = p.ml_conv + kk * 1024 + lane * 8; const float* wk = wq + 512;
#pragma unroll
          for (int q = 0; q < 4; ++q) { aq[2 * q] += wq[2 * q] * __uint_as_float(qv[q] << 16); aq[2 * q + 1] += wq[2 * q + 1] * __uint_as_float(qv[q] & 0xffff0000u);
            ak[2 * q] += wk[2 * q] * __uint_as_float(kv[q] << 16); ak[2 * q + 1] += wk[2 * q + 1] * __uint_as_float(kv[q] & 0xffff0000u); } } }
      u32x4 qo, ko;
#pragma unroll
      for (int q = 0; q < 4; ++q) { qo[q] = cvtpk(siluf(aq[2 * q]) * 0.08838834764831845f, siluf(aq[2 * q + 1]) * 0.08838834764831845f); ko[q] = cvtpk(siluf(ak[2 * q]), siluf(ak[2 * q + 1])); }
      *reinterpret_cast<u32x4*>(MQ + (size_t)r * 512 + lane * 8) = qo; *reinterpret_cast<u32x4*>(MK + (size_t)r * 512 + lane * 8) = ko; }
    { const u32x2 w = *reinterpret_cast<const u32x2*>(row + lane * 4);
      const float a0 = __uint_as_float(w[0] << 16), a1 = __uint_as_float(w[0] & 0xffff0000u), a2 = __uint_as_float(w[1] << 16), a3 = __uint_as_float(w[1] & 0xffff0000u);
      const float ss = wave_sum(a0 * a0 + a1 * a1 + a2 * a2 + a3 * a3);
      const float rstd = rsqrtf(ss * (1.f / 256.f) + EPS);
      const float4 g = *reinterpret_cast<const float4*>(p.mla_q_norm + lane * 4);
      u32x2 o = {cvtpk(a0 * rstd * g.x, a1 * rstd * g.y), cvtpk(a2 * rstd * g.z, a3 * rstd * g.w)};
      *reinterpret_cast<u32x2*>(CQN + (size_t)r * 256 + lane * 4) = o; }
    { const unsigned w = *reinterpret_cast<const unsigned*>(row + 256 + lane * 2);
      const float a0 = __uint_as_float(w << 16), a1 = __uint_as_float(w & 0xffff0000u);
      const float ss = wave_sum(a0 * a0 + a1 * a1);
      const float rstd = rsqrtf(ss * (1.f / 128.f) + EPS);
      const float2 g = *reinterpret_cast<const float2*>(p.mla_kv_norm + lane * 2);
      *reinterpret_cast<unsigned*>(CKVN + (size_t)r * 128 + lane * 2) = cvtpk(a0 * rstd * g.x, a1 * rstd * g.y); }
    { const int l = lane & 31;
      const float v = bf2f(row[384 + l]);
      const float pr = __shfl_xor(v, 8);
      float o = v;
      if (tt >= CTXL) { const int t = tt - CTXL, a = l >> 4, pp = (l >> 3) & 1, f = l & 7; const int pos = a == 0 ? (t >> 6) : (t & 63);
        const float2 cs = rm[pos * 8 + f]; o = v * cs.x + (pp ? pr : -pr) * cs.y; }
      if (lane < 32) KPE[(size_t)r * 32 + l] = f2bf(o); }
  }
}
__device__ __forceinline__ int tok_of(int dir, int j) { return dir == 0 ? j : (j < CTXL ? CTXL - 1 - j : TPB + CTXL - 1 - j); }
__device__ __forceinline__ float logsigf(float g) { return fminf(g, 0.f) - log1pf(expf(-fabsf(g))); }
struct MlLocal { float li0, li1, b0, b1, a0, a1, pe0, pm1, bend; };
__device__ __forceinline__ MlLocal mlstm_local(const float* __restrict__ G, float gbi, float gbf, int dir, int c, int lane) {
  MlLocal o;
  const int j0 = c * 128 + 2 * lane;
  const int t0 = tok_of(dir, j0), t1 = tok_of(dir, j0 + 1);
  o.li0 = G[(size_t)t0 * 16] + gbi; o.li1 = G[(size_t)t1 * 16] + gbi;
  const float lf0 = logsigf(G[(size_t)t0 * 16 + 4] + gbf), lf1 = logsigf(G[(size_t)t1 * 16 + 4] + gbf);
  float incl = lf0 + lf1;
#pragma unroll
  for (int o_ = 1; o_ < 64; o_ <<= 1) { const float v = __shfl_up(incl, o_); if (lane >= o_) incl += v; }
  o.b1 = incl; o.b0 = incl - lf1; o.bend = __shfl(incl, 63);
  o.a0 = o.li0 - o.b0; o.a1 = o.li1 - o.b1;
  float pmx = fmaxf(o.a0, o.a1);
#pragma unroll
  for (int o_ = 1; o_ < 64; o_ <<= 1) { const float v = __shfl_up(pmx, o_); if (lane >= o_) pmx = fmaxf(pmx, v); }
  float excl = __shfl_up(pmx, 1); if (lane == 0) excl = -3.0e38f;
  o.pe0 = fmaxf(excl, o.a0); o.pm1 = pmx;
  return o;
}
__device__ __forceinline__ void mlstm_scal(const Params& p, int chain, LP lds) {
  const int tid = my_tid(), wid = tid >> 6, lane = tid & 63;
  const int dir = chain & 1, h = (chain >> 1) & 3, b = chain >> 3;
  const float* G = (const float*)(p.ws + WS_GATES) + (size_t)b * TPB * 16 + dir * 8 + h;
  float4* SC = (float4*)(p.ws + WS_SCAL) + (size_t)chain * TPB;
  float* DEC = (float*)(p.ws + WS_DEC) + chain * 66;
  const float gbi = p.ml_gate_b[dir * 8 + h], gbf = p.ml_gate_b[dir * 8 + 4 + h];
  LAS float* BE = (LAS float*)lds; LAS float* PMs = BE + 66; LAS float* MC = PMs + 66;
  __syncthreads();
  for (int c = wid; c < 66; c += 8) { const MlLocal l = mlstm_local(G, gbi, gbf, dir, c, lane); if (lane == 63) { BE[c] = l.bend; PMs[c] = l.pm1; } }
  __syncthreads();
  if (tid == 0) { float m = 0.f; for (int c = 0; c < 66; ++c) { MC[c] = m; m = BE[c] + fmaxf(m, PMs[c]); } }
  __syncthreads();
  for (int c = wid; c < 66; c += 8) {
    const MlLocal l = mlstm_local(G, gbi, gbf, dir, c, lane);
    const float m = MC[c];
    const float M0 = fmaxf(m, l.pe0), M1 = fmaxf(m, l.pm1), Ml = fmaxf(m, PMs[c]);
    const int j0 = c * 128 + 2 * lane;
    SC[j0]     = make_float4(expf(l.a0 - Ml), expf(Ml - M0), expf(m - M0), expf(-(l.b0 + M0)));
    SC[j0 + 1] = make_float4(expf(l.a1 - Ml), expf(Ml - M1), expf(m - M1), expf(-(l.b1 + M1)));
    if (lane == 0) DEC[c] = expf(m - Ml);
  }
}
#define PK4(P, BASE, OUT) do { unsigned a0_ = cvtpk(P[BASE + 0], P[BASE + 1]), a1_ = cvtpk(P[BASE + 2], P[BASE + 3]);   \
    unsigned b0_ = cvtpk(P[BASE + 4], P[BASE + 5]), b1_ = cvtpk(P[BASE + 6], P[BASE + 7]);                              \
    auto r0_ = __builtin_amdgcn_permlane32_swap(a0_, b0_, false, false); auto r1_ = __builtin_amdgcn_permlane32_swap(a1_, b1_, false, false); \
    u32x4 w_ = {r0_[0], r1_[0], r0_[1], r1_[1]}; OUT = *reinterpret_cast<bf16x8*>(&w_); } while (0)
#define PKLH(L, H) (bf16x8){L[0], L[1], L[2], L[3], H[0], H[1], H[2], H[3]}
template <int T, int KS>
__device__ __forceinline__ void ml_pv_step(f32x16* acc, int vb_v, bf16x8 pa) {
  const s16x4 l0 = tr_read<T * 16384 + v_rd_off(0, KS, 0)>(vb_v), h0 = tr_read<T * 16384 + v_rd_off(0, KS, 1)>(vb_v);
  const s16x4 l1 = tr_read<T * 16384 + v_rd_off(1, KS, 0)>(vb_v), h1 = tr_read<T * 16384 + v_rd_off(1, KS, 1)>(vb_v);
  asm volatile("s_waitcnt lgkmcnt(0)" ::: "memory"); SBAR();
  acc[0] = __builtin_amdgcn_mfma_f32_32x32x16_bf16(pa, PKLH(l0, h0), acc[0], 0, 0, 0);
  acc[1] = __builtin_amdgcn_mfma_f32_32x32x16_bf16(pa, PKLH(l1, h1), acc[1], 0, 0, 0);
}
template <int T, int KS>
__device__ __forceinline__ void ml_cup_step(f32x16* Cacc, f32x16& nacc, int vb_k, int vb_v, bf16x8 ones) {
  const s16x4 ka = tr_read<T * 16384 + v_rd_off(0, KS, 0)>(vb_k), kh = tr_read<T * 16384 + v_rd_off(0, KS, 1)>(vb_k);
  const s16x4 l0 = tr_read<T * 16384 + v_rd_off(0, KS, 0)>(vb_v), h0 = tr_read<T * 16384 + v_rd_off(0, KS, 1)>(vb_v);
  const s16x4 l1 = tr_read<T * 16384 + v_rd_off(1, KS, 0)>(vb_v), h1 = tr_read<T * 16384 + v_rd_off(1, KS, 1)>(vb_v);
  asm volatile("s_waitcnt lgkmcnt(0)" ::: "memory"); SBAR();
  const bf16x8 af = PKLH(ka, kh);
  Cacc[0] = __builtin_amdgcn_mfma_f32_32x32x16_bf16(af, PKLH(l0, h0), Cacc[0], 0, 0, 0);
  Cacc[1] = __builtin_amdgcn_mfma_f32_32x32x16_bf16(af, PKLH(l1, h1), Cacc[1], 0, 0, 0);
  nacc = __builtin_amdgcn_mfma_f32_32x32x16_bf16(af, ones, nacc, 0, 0, 0);
}
__device__ __forceinline__ void mlstm_chain(const Params& p, int chain, LP lds) {
  const int tid = my_tid(), wid = tid >> 6, lane = tid & 63, r32 = lane & 31, hi = lane >> 5;
  const int tb = wid & 3, eh = wid >> 2, db = wid & 3;
  const int dir = chain & 1, h = (chain >> 1) & 3, b = chain >> 3;
  const LP KR = lds, KT = lds + 32768, VT = lds + 65536, CT = lds + 98304;
  LAS float* NV = (LAS float*)(lds + 131072); LAS float* WSs = NV + 128; LAS float* IFs = WSs + 128; LAS float* DENs = IFs + 128 + wid * 32;
  const bf16_t* MQ = (const bf16_t*)p.out + (size_t)b * TPB * 512 + h * 128;
  const bf16_t* MK = MQ + (size_t)R * 512;
  const bf16_t* VG = (const bf16_t*)(p.ws + WS_P0) + (size_t)b * TPB * P0W + 1440 + h * 128;
  bf16_t* HO = (bf16_t*)(p.ws + (dir == 0 ? WS_HF : WS_HB)) + (size_t)b * TPB * 512 + h * 128;
  const float4* SC = (const float4*)(p.ws + WS_SCAL) + (size_t)chain * TPB;
  const float* DEC = (const float*)(p.ws + WS_DEC) + chain * 66;
  __syncthreads();
  for (int i = tid; i < 2048; i += NTHREADS) *reinterpret_cast<LAS u32x4*>(CT + i * 16) = u32x4{0u, 0u, 0u, 0u};
  if (tid < 128) NV[tid] = 0.f;
  f32x16 Cacc[2], nacc;
  Cacc[0] = f32x16{}; Cacc[1] = f32x16{}; nacc = f32x16{};
  const int sr = tid >> 4, sc = (tid & 15) * 8;
  const int vrb = v_rd_base(lane);
  const int vb_v = (int)(unsigned)(size_t)VT + vrb + eh * 1024;
  const int vb_k = (int)(unsigned)(size_t)KT + vrb + db * 512;
  const short one_s = (short)0x3F80;
  const bf16x8 ones = {one_s, one_s, one_s, one_s, one_s, one_s, one_s, one_s};
  for (int c = 0; c < 66; ++c) {
    const int jb = c * 128;
    bf16x8 kreg[4], vreg[4]; float wks[4];
#pragma unroll
    for (int i = 0; i < 4; ++i) { const int j = jb + sr + 32 * i; const int tt = tok_of(dir, j);
      kreg[i] = *reinterpret_cast<const bf16x8*>(MK + (size_t)tt * 512 + sc);
      vreg[i] = *reinterpret_cast<const bf16x8*>(VG + (size_t)tt * P0W + sc);
      wks[i] = SC[j].x; }
    const int jq = jb + 32 * tb + r32; const int ttq = tok_of(dir, jq);
    bf16x8 qr[8];
#pragma unroll
    for (int d0 = 0; d0 < 8; ++d0) qr[d0] = *reinterpret_cast<const bf16x8*>(MQ + (size_t)ttq * 512 + d0 * 16 + hi * 8);
    const float4 scq = SC[jq];
    float4 s4 = make_float4(0.f, 0.f, 0.f, 0.f);
    if (tid < 128) s4 = SC[jb + tid];
    const float decay = DEC[c];
    __syncthreads();
    if (tid < 128) { WSs[tid] = s4.z; IFs[tid] = s4.w; }
    if (c > 0) {
#pragma unroll
      for (int e1 = 0; e1 < 2; ++e1) { const int erow = 64 * eh + 32 * e1 + r32;
#pragma unroll
        for (int g = 0; g < 4; ++g) { const int d = 32 * db + 8 * g + 4 * hi;
          u32x2 w = {cvtpk(Cacc[e1][4 * g], Cacc[e1][4 * g + 1]), cvtpk(Cacc[e1][4 * g + 2], Cacc[e1][4 * g + 3])};
          *reinterpret_cast<LAS u32x2*>(CT + KSWZ(erow, d * 2)) = w; } }
      if (eh == 0 && r32 == 0) {
#pragma unroll
        for (int r = 0; r < 16; ++r) NV[32 * db + crow(r, hi)] = nacc[r]; }
    }
#pragma unroll
    for (int i = 0; i < 4; ++i) {
      const u32x4 kw = *reinterpret_cast<const u32x4*>(&kreg[i]); const float w = wks[i];
      u32x4 ko;
#pragma unroll
      for (int q = 0; q < 4; ++q) ko[q] = cvtpk(__uint_as_float(kw[q] << 16) * w, __uint_as_float(kw[q] & 0xffff0000u) * w);
      const int row = sr + 32 * i, tl = i >> 1, kin = sr + 32 * (i & 1);
      *reinterpret_cast<LAS u32x4*>(KR + KSWZ(row, sc * 2)) = ko;
      *reinterpret_cast<LAS u32x4*>(KT + tl * 16384 + v_st(kin, sc)) = ko;
      *reinterpret_cast<LAS bf16x8*>(VT + tl * 16384 + v_st(kin, sc)) = vreg[i];
    }
    __syncthreads();
    bf16x8 pa[8]; float dsum = 0.f;
#pragma unroll
    for (int kb = 0; kb < 4; ++kb) {
      if (kb <= tb) {
        f32x16 pp = f32x16{};
#pragma unroll
        for (int d0 = 0; d0 < 8; ++d0) { const int cb = (d0 * 16 + hi * 8) * 2;
          const bf16x8 a = *reinterpret_cast<const LAS bf16x8*>(KR + KSWZ(32 * kb + r32, cb));
          pp = __builtin_amdgcn_mfma_f32_32x32x16_bf16(a, qr[d0], pp, 0, 0, 0); }
#pragma unroll
        for (int r = 0; r < 16; ++r) { const bool ok = (kb < tb) || (crow(r, hi) <= r32); const float v = ok ? pp[r] * scq.y : 0.f; pp[r] = v; dsum += v; }
        PK4(pp, 0, pa[2 * kb]); PK4(pp, 8, pa[2 * kb + 1]);
      } else { pa[2 * kb] = bf16x8{0, 0, 0, 0, 0, 0, 0, 0}; pa[2 * kb + 1] = bf16x8{0, 0, 0, 0, 0, 0, 0, 0}; }
    }
    { auto rr = __builtin_amdgcn_permlane32_swap(__float_as_uint(dsum), __float_as_uint(dsum), false, false);
      dsum = __uint_as_float(rr[0]) + __uint_as_float(rr[1]); }
    f32x16 acc[2]; acc[0] = f32x16{}; acc[1] = f32x16{};
#pragma unroll
    for (int ds = 0; ds < 8; ++ds) { const int cb = (ds * 16 + hi * 8) * 2;
      const bf16x8 c0 = *reinterpret_cast<const LAS bf16x8*>(CT + KSWZ(64 * eh + r32, cb));
      const bf16x8 c1 = *reinterpret_cast<const LAS bf16x8*>(CT + KSWZ(64 * eh + 32 + r32, cb));
      acc[0] = __builtin_amdgcn_mfma_f32_32x32x16_bf16(qr[ds], c0, acc[0], 0, 0, 0);
      acc[1] = __builtin_amdgcn_mfma_f32_32x32x16_bf16(qr[ds], c1, acc[1], 0, 0, 0); }
    float qn = 0.f;
#pragma unroll
    for (int d0 = 0; d0 < 8; ++d0) { const u32x4 qw = *reinterpret_cast<const u32x4*>(&qr[d0]);
#pragma unroll
      for (int q = 0; q < 4; ++q) { qn += __uint_as_float(qw[q] << 16) * NV[d0 * 16 + hi * 8 + 2 * q] + __uint_as_float(qw[q] & 0xffff0000u) * NV[d0 * 16 + hi * 8 + 2 * q + 1]; } }
    { auto rr = __builtin_amdgcn_permlane32_swap(__float_as_uint(qn), __float_as_uint(qn), false, false);
      qn = __uint_as_float(rr[0]) + __uint_as_float(rr[1]); }
    const float den = scq.z * qn + dsum;
    if (hi == 0) DENs[r32] = den;
#pragma unroll
    for (int r = 0; r < 16; ++r) { const float w = WSs[32 * tb + crow(r, hi)]; acc[0][r] *= w; acc[1][r] *= w; }
    ml_pv_step<0, 0>(acc, vb_v, pa[0]); ml_pv_step<0, 1>(acc, vb_v, pa[1]);
    if (tb >= 1) { ml_pv_step<0, 2>(acc, vb_v, pa[2]); ml_pv_step<0, 3>(acc, vb_v, pa[3]); }
    if (tb >= 2) { ml_pv_step<1, 0>(acc, vb_v, pa[4]); ml_pv_step<1, 1>(acc, vb_v, pa[5]); }
    if (tb >= 3) { ml_pv_step<1, 2>(acc, vb_v, pa[6]); ml_pv_step<1, 3>(acc, vb_v, pa[7]); }
    { const int ttb = tok_of(dir, jb), stp = dir ? -1 : 1;
#pragma unroll
      for (int r = 0; r < 16; ++r) { const int t = 32 * tb + crow(r, hi);
        const float rd = 1.f / fmaxf(fabsf(DENs[crow(r, hi)]), IFs[t]);
        bf16_t* o = HO + (size_t)(ttb + stp * t) * 512 + 64 * eh + r32;
        o[0] = f2bf(acc[0][r] * rd); o[32] = f2bf(acc[1][r] * rd); } }
#pragma unroll
    for (int r = 0; r < 16; ++r) { Cacc[0][r] *= decay; Cacc[1][r] *= decay; nacc[r] *= decay; }
    ml_cup_step<0, 0>(Cacc, nacc, vb_k, vb_v, ones); ml_cup_step<0, 1>(Cacc, nacc, vb_k, vb_v, ones);
    ml_cup_step<0, 2>(Cacc, nacc, vb_k, vb_v, ones); ml_cup_step<0, 3>(Cacc, nacc, vb_k, vb_v, ones);
    ml_cup_step<1, 0>(Cacc, nacc, vb_k, vb_v, ones); ml_cup_step<1, 1>(Cacc, nacc, vb_k, vb_v, ones);
    ml_cup_step<1, 2>(Cacc, nacc, vb_k, vb_v, ones); ml_cup_step<1, 3>(Cacc, nacc, vb_k, vb_v, ones);
  }
}
__device__ __forceinline__ void phase_mix0(const Params& p, LP lds) {
  if (blockIdx.x < 32) mlstm_chain(p, blockIdx.x, lds);
  const int tid = my_tid(), sc = (tid & 15) * 8;
  const bf16_t* KV = (const bf16_t*)(p.ws + WS_KV); const bf16_t* QM = (const bf16_t*)(p.ws + WS_QM); const bf16_t* KPE = (const bf16_t*)(p.ws + WS_KPE);
  bf16_t* MIX = (bf16_t*)(p.ws + WS_H);
  const float scale = 0.10206207261596577f;
  const float Cs = scale * 1.4426950408889634f, thr = 8.f / scale;
  int* ctr = (int*)(p.ws + WS_CTR) + (blockIdx.x & 7);
  LAS int* slot = (LAS int*)(lds + 69632);
  for (;;) {
    __syncthreads();
    if (tid == 0) *slot = atomicAdd(ctr, 1);
    __syncthreads();
    const int t = *slot;
    if (t >= 132) break;
    int b, h, row0, seq;
    if (t < 128) { const int bh = (t >> 5) * 8 + (blockIdx.x & 7), qb = t & 31; b = bh >> 3; h = bh & 7; row0 = b * TPB + CTXL + qb * 256; seq = TPB; }
    else { const int bh = (t - 128) * 8 + (blockIdx.x & 7); b = bh >> 3; h = bh & 7; row0 = b * TPB; seq = CTXL; }
    const size_t kb = (size_t)b * TPB;
    const bf16_t* kptr = sc < 64 ? KV + kb * 1024 + h * 128 + sc : KPE + kb * 32 + ((sc - 64) & 31);
    const int kstr = sc < 64 ? 1024 : 32;
    const bf16_t* vptr = KV + kb * 1024 + h * 128 + 64 + (sc & 63);
    attn_body<6, 2>(QM + (size_t)row0 * 768 + h * 96, 768, kptr, kstr, vptr, 1024, MIX + (size_t)row0 * 1024 + h * 64, 1024, seq, Cs, thr, lds);
  }
}
__device__ __forceinline__ void phase_readout(const Params& p) {
  const int lane = my_tid() & 63, gw = blockIdx.x * 8 + (my_tid() >> 6), nw = gridDim.x * 8;
  const bf16_t* P0 = (const bf16_t*)(p.ws + WS_P0); const bf16_t* HF = (const bf16_t*)(p.ws + WS_HF); const bf16_t* HB = (const bf16_t*)(p.ws + WS_HB);
  bf16_t* MIX = (bf16_t*)(p.ws + WS_H);
  for (int r = gw; r < R; r += nw) {
    const int c = lane * 8;
    const u32x4 a = *reinterpret_cast<const u32x4*>(HF + (size_t)r * 512 + c), bb = *reinterpret_cast<const u32x4*>(HB + (size_t)r * 512 + c);
    const u32x4 ov = *reinterpret_cast<const u32x4*>(P0 + (size_t)r * P0W + 1952 + c);
    float hs[8], og[8]; float ss = 0.f;
#pragma unroll
    for (int i = 0; i < 4; ++i) { hs[2 * i] = __uint_as_float(a[i] << 16) + __uint_as_float(bb[i] << 16); hs[2 * i + 1] = __uint_as_float(a[i] & 0xffff0000u) + __uint_as_float(bb[i] & 0xffff0000u);
      og[2 * i] = __uint_as_float(ov[i] << 16); og[2 * i + 1] = __uint_as_float(ov[i] & 0xffff0000u); }
#pragma unroll
    for (int i = 0; i < 8; ++i) ss += hs[i] * hs[i];
    ss += __shfl_xor(ss, 1); ss += __shfl_xor(ss, 2); ss += __shfl_xor(ss, 4); ss += __shfl_xor(ss, 8);
    const float rstd = rsqrtf(ss * (1.f / 128.f) + EPS);
    float o[8];
#pragma unroll
    for (int i = 0; i < 8; ++i) o[i] = sigmoidf(og[i]) * hs[i] * rstd * p.ml_head_norm[c + i];
    u32x4 w = {cvtpk(o[0], o[1]), cvtpk(o[2], o[3]), cvtpk(o[4], o[5]), cvtpk(o[6], o[7])};
    *reinterpret_cast<u32x4*>(MIX + (size_t)r * 1024 + 512 + c) = w;
  }
}
__device__ __forceinline__ void phase_prep1(const Params& p) {
  const int lane = my_tid() & 63, gw = blockIdx.x * 8 + (my_tid() >> 6), nw = gridDim.x * 8;
  bf16_t* Q = (bf16_t*)(p.ws + WS_QKV1);
  const float2* rg = (const float2*)(p.ws + WS_ROPEG);
  for (int r = gw; r < R; r += nw) {
    const int b = r / TPB, tt = r - b * TPB;
    bf16_t* row = Q + (size_t)r * 1536;
    const int pp = lane >> 5, f = lane & 31;
    float2 cs0 = make_float2(1.f, 0.f), cs1 = make_float2(1.f, 0.f);
    if (tt >= CTXL) { const int t = tt - CTXL; cs0 = rg[(t >> 6) * 32 + f]; cs1 = rg[(t & 63) * 32 + f]; }
    for (int hd = (tt < CTXL ? 8 : 0); hd < 10; ++hd) {
      const float* gn = hd < 8 ? p.q_norm1 : p.k_norm1;
      const float v0 = bf2f(row[hd * 128 + lane]), v1 = bf2f(row[hd * 128 + 64 + lane]);
      const float ss = wave_sum(v0 * v0 + v1 * v1);
      const float rstd = rsqrtf(ss * (1.f / 128.f) + EPS);
      const float y0 = v0 * rstd * gn[lane], y1 = v1 * rstd * gn[64 + lane];
      const float p0 = __shfl_xor(y0, 32), p1 = __shfl_xor(y1, 32);
      const float o0 = y0 * cs0.x + (pp ? p0 : -p0) * cs0.y, o1 = y1 * cs1.x + (pp ? p1 : -p1) * cs1.y;
      row[hd * 128 + lane] = f2bf(o0); row[hd * 128 + 64 + lane] = f2bf(o1);
    }
  }
}
__device__ __forceinline__ void phase_mix1(const Params& p, LP lds) {
  const int tid = my_tid(), sc = (tid & 15) * 8;
  const bf16_t* Q = (const bf16_t*)(p.ws + WS_QKV1); bf16_t* MIX = (bf16_t*)(p.ws + WS_H);
  const float scale = 0.08838834764831845f;
  const float Cs = scale * 1.4426950408889634f, thr = 8.f / scale;
  for (int t = blockIdx.x; t < 1024; t += gridDim.x) {
    const int blkv = t & 255, rnd = t >> 8, bh = rnd * 8 + (blkv & 7), qb = blkv >> 3, b = bh >> 3, h = bh & 7, kvh = h >> 2;
    const int row0 = b * TPB + CTXL + qb * 256;
    const size_t kb = (size_t)b * TPB;
    attn_body<8, 4>(Q + (size_t)row0 * 1536 + h * 128, 1536, Q + kb * 1536 + 1024 + kvh * 128 + sc, 1536, Q + kb * 1536 + 1280 + kvh * 128 + sc, 1536,
                    MIX + (size_t)row0 * 1024 + h * 128, 1024, TPB, Cs, thr, lds);
  }
}
__device__ __forceinline__ void phase_final(const Params& p) {
  const int lane = my_tid() & 63, gw = blockIdx.x * 8 + (my_tid() >> 6), nw = gridDim.x * 8;
  for (int r = gw; r < NB * SEQ; r += nw) {
    float* row = p.out + (size_t)r * DM;
    float4 v[4]; float ss = 0;
#pragma unroll
    for (int i = 0; i < 4; ++i) { v[i] = *reinterpret_cast<const float4*>(row + i * 256 + lane * 4); ss += v[i].x * v[i].x + v[i].y * v[i].y + v[i].z * v[i].z + v[i].w * v[i].w; }
    ss = wave_sum(ss);
    const float rstd = rsqrtf(ss * (1.f / 1024.f) + EPS);
#pragma unroll
    for (int i = 0; i < 4; ++i) { const float4 g = *reinterpret_cast<const float4*>(p.final_norm + i * 256 + lane * 4);
      *reinterpret_cast<float4*>(row + i * 256 + lane * 4) = make_float4(v[i].x * rstd * g.x, v[i].y * rstd * g.y, v[i].z * rstd * g.z, v[i].w * rstd * g.w); }
  }
}

__device__ __forceinline__ void phase_gemm_in0(const Params& p, LP lds) {
  const bf16_t* H = (const bf16_t*)(p.ws + WS_H); const bf16_t* WT = (const bf16_t*)(p.ws + WS_WT0_IN);
  bf16_t* P0 = (bf16_t*)(p.ws + WS_P0); float* G = (float*)(p.ws + WS_GATES);
  bool pre = false;
  for (int t = blockIdx.x; t < 132 * 10; t += gridDim.x) {
    const int mt = t / 10, nt = t % 10, row0 = mt * 256, col0 = nt * 256;
    const int tn = t + gridDim.x; const bool hasn = tn < 132 * 10; const int rown = (tn / 10) * 256, coln = (tn % 10) * 256;
    gemm8p(H + (size_t)row0 * 1024, 1024, WT + (size_t)col0 * 1024, 1024, 1024, lds, [&](int rr, int cc, int hi, f32x16 v) __attribute__((always_inline)) {
      const int col = col0 + cc;
#pragma unroll
      for (int r = 0; r < 16; ++r) { const size_t row = row0 + rr + crow(r, hi);
        if (col < P0W) P0[row * P0W + col] = f2bf(v[r]); else if (col < 2480) G[row * 16 + (col - P0W)] = v[r]; }
    }, pre, hasn ? H + (size_t)rown * 1024 : nullptr, hasn ? WT + (size_t)coln * 1024 : nullptr);
    pre = hasn;
  }
}
__device__ __forceinline__ void phase_gemm_up0(const Params& p, LP lds) {
  const bf16_t* CQN = (const bf16_t*)(p.ws + WS_CQN); const bf16_t* CKVN = (const bf16_t*)(p.ws + WS_CKVN);
  const bf16_t* WQ = (const bf16_t*)(p.ws + WS_WT0_UQ); const bf16_t* WKV = (const bf16_t*)(p.ws + WS_WT0_UKV);
  bf16_t* QM = (bf16_t*)(p.ws + WS_QM); bf16_t* KV = (bf16_t*)(p.ws + WS_KV);
  const float2* rm = (const float2*)(p.ws + WS_ROPEM);
  for (int t = blockIdx.x; t < 132 * 7; t += gridDim.x) {
    const int mt = t / 7, nt = t % 7, row0 = mt * 256;
    if (nt < 3) {
      const int col0 = nt * 256;
      const bool isx = (row0 % TPB) >= CTXL;
      const int tk0 = (row0 % TPB) - CTXL;
      gemm256(CQN + (size_t)row0 * 256, 256, WQ + (size_t)col0 * 256, 256, 256, lds, [&](int rr, int cc, int hi, f32x16 v) __attribute__((always_inline)) {
        const int col = col0 + cc, d = col % 96;
        const bool rot = isx && d >= 64;
        const int idx = d - 64, a = (idx >> 4) & 1, pp = (idx >> 3) & 1, f = idx & 7;
#pragma unroll
        for (int r = 0; r < 16; ++r) { const int row = row0 + rr + crow(r, hi);
          float o = v[r];
          const float pr = __shfl_xor(o, 8);
          if (rot) { const int tk = tk0 + rr + crow(r, hi); const int pos = a == 0 ? (tk >> 6) : (tk & 63); const float2 cs = rm[pos * 8 + f]; o = o * cs.x + (pp ? pr : -pr) * cs.y; }
          QM[(size_t)row * 768 + col] = f2bf(o); }
      });
    } else {
      const int col0 = (nt - 3) * 256;
      gemm256(CKVN + (size_t)row0 * 128, 128, WKV + (size_t)col0 * 128, 128, 128, lds, [&](int rr, int cc, int hi, f32x16 v) __attribute__((always_inline)) {
        const int col = col0 + cc;
#pragma unroll
        for (int r = 0; r < 16; ++r) { const size_t row = row0 + rr + crow(r, hi); KV[row * 1024 + col] = f2bf(v[r]); }
      });
    }
  }
}
__device__ __forceinline__ void phase_gemm_res(const Params& p, int L, const bf16_t* __restrict__ A, int K, const bf16_t* __restrict__ WT, int gate_slot, bool from_input, bool xonly, LP lds) {
  const float* mods = (const float*)(p.ws + WS_MODS) + (size_t)L * 5 * 6144 + gate_slot * 1024;
  auto tile_of = [&](int t, int& row0, int& col0) __attribute__((always_inline)) -> bool {
    if (t >= 512) return false;
    const int tv = t & 255, rnd = t >> 8, xl = tv & 7, lc = tv >> 3;
    row0 = tile_row_x(rnd * 64 + xl * 8 + (lc >> 2)); col0 = (lc & 3) * 256; return true; };
  bool pre = false;
  for (int t = blockIdx.x; t < 512; t += gridDim.x) {
    int row0 = 0, col0 = 0, rown = 0, coln = 0;
    tile_of(t, row0, col0);
    const bool hasn = tile_of(t + gridDim.x, rown, coln);
    const float* gate = mods + (size_t)mod_idx(row0) * 6144;
    const float* resb = from_input ? in_row(p, row0) : s_row(p, row0);
    float* sb = s_row(p, row0);
    gemm8p(A + (size_t)row0 * K, K, WT + (size_t)col0 * K, K, K, lds, [&](int rr, int cc, int hi, f32x16 v) __attribute__((always_inline)) {
      const int col = col0 + cc; const float g = gate[col];
#pragma unroll
      for (int r = 0; r < 16; ++r) { const size_t o = (size_t)(rr + crow(r, hi)) * DM + col; sb[o] = resb[o] + g * v[r]; }
    }, pre, hasn ? A + (size_t)rown * K : nullptr, hasn ? WT + (size_t)coln * K : nullptr);
    pre = hasn;
  }
  if (!xonly) {
    const int ks = K >> 8;
    const float* gate = mods + (size_t)4 * 6144;
    for (int it = blockIdx.x; it < 16 * ks; it += gridDim.x) {
      const int ct = it / ks, sl = it - ct * ks, b = ct >> 2, nt = ct & 3, row0 = b * TPB, col0 = nt * 256, k0 = sl * 256;
      float* sb = (float*)(p.ws + WS_SCTX) + (size_t)b * CTXL * DM;
      gemm8p(A + (size_t)row0 * K + k0, K, WT + (size_t)col0 * K + k0, K, 256, lds, [&](int rr, int cc, int hi, f32x16 v) __attribute__((always_inline)) {
        const int col = col0 + cc; const float g = gate[col];
#pragma unroll
        for (int r = 0; r < 16; ++r) { const size_t o = (size_t)(rr + crow(r, hi)) * DM + col; unsafeAtomicAdd(&sb[o], g * v[r]); }
      });
    }
  }
}
__device__ __forceinline__ void phase_gemm_w1(const Params& p, const bf16_t* __restrict__ WT, bool xonly, LP lds) {
  const bf16_t* H = (const bf16_t*)(p.ws + WS_H); bf16_t* U = (bf16_t*)(p.ws + WS_U);
  const int nmt = xonly ? 128 : 132;
  auto tile_of = [&](int t, int& row0, int& col0) __attribute__((always_inline)) -> bool {
    if (t >= 144 * 16) return false;
    const int tv = t & 255, rnd = t >> 8, xl = tv & 7, lc = tv >> 3;
    const int mt = rnd * 16 + (xl >> 1) * 4 + (lc >> 3), nt = (xl & 1) * 8 + (lc & 7);
    if (mt >= nmt) return false;
    row0 = xonly ? tile_row_x(mt) : tile_row_all(mt); col0 = nt * 256; return true; };
  bool pre = false;
  for (int t = blockIdx.x; t < 144 * 16; t += gridDim.x) {
    int row0 = 0, col0 = 0, rown = 0, coln = 0;
    if (!tile_of(t, row0, col0)) continue;
    const bool hasn = tile_of(t + gridDim.x, rown, coln);
    gemm8p(H + (size_t)row0 * 1024, 1024, WT + (size_t)col0 * 1024, 1024, 1024, lds, [&](int rr, int cc, int hi, f32x16 v) __attribute__((always_inline)) {
      const int col = col0 + cc;
#pragma unroll
      for (int r = 0; r < 16; ++r) { const size_t row = row0 + rr + crow(r, hi); const float a = fmaxf(v[r], 0.f); U[row * 4096 + col] = f2bf(a * a); }
    }, pre, hasn ? H + (size_t)rown * 1024 : nullptr, hasn ? WT + (size_t)coln * 1024 : nullptr);
    pre = hasn;
  }
}
__device__ __forceinline__ void phase_gemm_in1(const Params& p, LP lds) {
  const bf16_t* H = (const bf16_t*)(p.ws + WS_H); const bf16_t* WT = (const bf16_t*)(p.ws + WS_WT1_IN); bf16_t* Q = (bf16_t*)(p.ws + WS_QKV1);
  bool pre = false;
  for (int t = blockIdx.x; t < 132 * 6; t += gridDim.x) {
    const int mt = t / 6, nt = t % 6, row0 = mt * 256, col0 = nt * 256;
    const int tn = t + gridDim.x; const bool hasn = tn < 132 * 6; const int rown = (tn / 6) * 256, coln = (tn % 6) * 256;
    gemm8p(H + (size_t)row0 * 1024, 1024, WT + (size_t)col0 * 1024, 1024, 1024, lds, [&](int rr, int cc, int hi, f32x16 v) __attribute__((always_inline)) {
      const int col = col0 + cc;
#pragma unroll
      for (int r = 0; r < 16; ++r) { const size_t row = row0 + rr + crow(r, hi); Q[row * 1536 + col] = f2bf(v[r]); }
    }, pre, hasn ? H + (size_t)rown * 1024 : nullptr, hasn ? WT + (size_t)coln * 1024 : nullptr);
    pre = hasn;
  }
}

__device__ __forceinline__ void run_phase(const Params& p, int ph, LP lds) {
  char* ws = p.ws;
  switch (ph) {
    case 0: phase_prep(p, lds); break;
    case 1: phase_mods(p); break;
    case 2: phase_norm(p, 0, 0, p.norm1[0], 0, false); break;
    case 3: phase_gemm_in0(p, lds); break;
    case 4: phase_prep0(p, lds); break;
    case 5: phase_gemm_up0(p, lds); break;
    case 6: phase_mix0(p, lds); break;
    case 7: phase_readout(p); break;
    case 8: phase_gemm_res(p, 0, (const bf16_t*)(ws + WS_H), 1024, (const bf16_t*)(ws + WS_WT0_OUT), 2, true, false, lds); break;
    case 9: phase_norm(p, 0, 1, p.norm2[0], 3, false); break;
    case 10: phase_gemm_w1(p, (const bf16_t*)(ws + WS_WT0_W1), false, lds); break;
    case 11: phase_gemm_res(p, 0, (const bf16_t*)(ws + WS_U), 4096, (const bf16_t*)(ws + WS_WT0_W2), 5, false, false, lds); break;
    case 12: phase_norm(p, 1, 1, p.norm1[1], 0, false); break;
    case 13: phase_gemm_in1(p, lds); break;
    case 14: phase_prep1(p); break;
    case 15: phase_mix1(p, lds); break;
    case 16: phase_gemm_res(p, 1, (const bf16_t*)(ws + WS_H), 1024, (const bf16_t*)(ws + WS_WT1_OUT), 2, false, true, lds); break;
    case 17: phase_norm(p, 1, 1, p.norm2[1], 3, true); break;
    case 18: phase_gemm_w1(p, (const bf16_t*)(ws + WS_WT1_W1), true, lds); break;
    case 19: phase_gemm_res(p, 1, (const bf16_t*)(ws + WS_U), 4096, (const bf16_t*)(ws + WS_WT1_W2), 5, false, true, lds); break;
    case 20: phase_final(p); break;
    default: break;
  }
}

#if MEGA
#define XB_TMO      128
#define XB_XCNT(j)  (256  + 64 * (j))
#define XB_XSUB(j)  (1280 + 64 * (j))
#define XB_XGEN(j)  (2304 + 64 * (j))
#define XB_TOP      3328
#define XB_TOPGEN   3392
#define XB_SPIN_CAP (1u << 18)
__device__ __forceinline__ unsigned xb_ld(unsigned* p)              { return __hip_atomic_load(p, __ATOMIC_RELAXED, __HIP_MEMORY_SCOPE_AGENT); }
__device__ __forceinline__ unsigned xb_add(unsigned* p, unsigned v) { return __hip_atomic_fetch_add(p, v, __ATOMIC_RELAXED, __HIP_MEMORY_SCOPE_AGENT); }
__device__ __forceinline__ unsigned xb_xcc_id() { return (unsigned)__builtin_amdgcn_s_getreg((3 << 11) | 20) & 0xFu; }
#define XB_SPIN(cond, bar) do { unsigned _sp = 0; while (cond) { __builtin_amdgcn_s_sleep(1); \
    if ((++_sp & 255u) == 0u) { if (xb_ld(&(bar)[XB_TMO])) break; if (_sp > XB_SPIN_CAP) { atomicAdd(&(bar)[XB_TMO], 1u); break; } } } } while (0)
struct XcdBarrier { unsigned* bar; unsigned x; volatile LAS unsigned* st; };
__device__ __forceinline__ XcdBarrier xcd_barrier_post(unsigned* bar, volatile LAS unsigned* st) {
  XcdBarrier b; b.bar = bar; b.x = xb_xcc_id(); b.st = st;
  if (threadIdx.x == 0) (void)xb_add(&bar[XB_XCNT(b.x)], 1u);
  return b;
}
__device__ __forceinline__ void xcd_barrier_complete(unsigned* bar, unsigned x, unsigned& nloc, unsigned& nx) {
  const unsigned G = gridDim.x;
  unsigned sum, cnt, mine, sp = 0u;
  for (;;) {
    sum = 0u; cnt = 0u; mine = 0u;
#pragma unroll
    for (unsigned j = 0; j < 16; ++j) { const unsigned c = xb_ld(&bar[XB_XCNT(j)]); sum += c; cnt += (c > 0u) ? 1u : 0u; mine = (j == x) ? c : mine; }
    if (sum == G) break;
    __builtin_amdgcn_s_sleep(1);
    if ((++sp & 255u) == 0u) { if (xb_ld(&bar[XB_TMO])) break; if (sp > XB_SPIN_CAP) { atomicAdd(&bar[XB_TMO], 1u); break; } }
  }
  nloc = mine > 0u ? mine : 1u; nx = cnt > 0u ? cnt : 1u;
}
__device__ __forceinline__ void xcd_barrier(const XcdBarrier& b) {
  asm volatile("s_waitcnt vmcnt(0)" ::: "memory");
  __syncthreads();
  if (threadIdx.x == 0) {
    unsigned* bar = b.bar;
    __builtin_amdgcn_s_waitcnt(0);
    unsigned nloc = b.st[0], nx = b.st[1];
    if (nloc == 0u) { xcd_barrier_complete(bar, b.x, nloc, nx); b.st[0] = nloc; b.st[1] = nx; }
    const unsigned old = xb_add(&bar[XB_XSUB(b.x)], 1u);
    const unsigned gen = old / nloc;
    if (old + 1u == (gen + 1u) * nloc) {
      __builtin_amdgcn_fence(__ATOMIC_RELEASE, "agent");
      asm volatile("s_waitcnt vmcnt(0)" ::: "memory");
      const unsigned og = xb_add(&bar[XB_TOP], 1u);
      const unsigned tg = og / nx;
      if (og + 1u == (tg + 1u) * nx) xb_add(&bar[XB_TOPGEN], 1u);
      else XB_SPIN(xb_ld(&bar[XB_TOPGEN]) == tg, bar);
      __builtin_amdgcn_fence(__ATOMIC_ACQUIRE, "agent");
      xb_add(&bar[XB_XGEN(b.x)], 1u);
      asm volatile("s_waitcnt vmcnt(0)" ::: "memory");
    } else {
      XB_SPIN(xb_ld(&bar[XB_XGEN(b.x)]) == gen, bar);
      __builtin_amdgcn_fence(__ATOMIC_ACQUIRE, "agent");
      asm volatile("s_waitcnt vmcnt(0)" ::: "memory");
    }
  }
  __syncthreads();
}
#define PH(n) run_phase(p, n, lds); xcd_barrier(xb);
__global__ void __launch_bounds__(NTHREADS) fwd_kernel(Params p) {
  extern __shared__ __attribute__((aligned(16))) char lds_raw[];
  const LP lds = (LP)lds_raw;
  cg::grid_group grid = cg::this_grid();
  volatile LAS unsigned* xst = (volatile LAS unsigned*)(lds + 135168);
  if (threadIdx.x == 0) { xst[0] = 0u; xst[1] = 0u; }
  __syncthreads();
  const XcdBarrier xb = xcd_barrier_post((unsigned*)(p.ws + WS_XBAR), xst);
  PH(0)
  run_phase(p, 1, lds); grid.sync();
  PH(2) PH(3) PH(4) PH(5) PH(6) PH(7) PH(8) PH(9) PH(10) PH(11) PH(12) PH(13) PH(14) PH(15) PH(16) PH(17) PH(18) PH(19)
  run_phase(p, 20, lds);
}
#else
template <int PHN>
__global__ void __launch_bounds__(NTHREADS) fwd_kernel(Params p) {
  extern __shared__ __attribute__((aligned(16))) char lds_raw[];
  run_phase(p, PHN, (LP)lds_raw);
}
template <int PHN> static void launch_phase(const Params& p, int grid, hipStream_t stream) {
  static bool attr = false;
  if (!attr) { (void)hipFuncSetAttribute((const void*)fwd_kernel<PHN>, hipFuncAttributeMaxDynamicSharedMemorySize, LDS_BYTES); attr = true; }
  hipLaunchKernelGGL(fwd_kernel<PHN>, dim3(grid), dim3(NTHREADS), LDS_BYTES, stream, p);
}
#endif

extern "C" void kernel_launch(void* const* d_in, const int* in_sizes, int n_in, void* d_out, int out_size, void* d_ws, size_t ws_size, hipStream_t stream) {
  static int grid_blocks = 0;
  if (!grid_blocks) {
    if (n_in != 30 || ws_size < WS_NEED || out_size != NB * SEQ * DM) { fprintf(stderr, "kernel_launch: unexpected shapes (n_in %d ws %zu need %zu out %d)\n", n_in, ws_size, (size_t)WS_NEED, out_size); return; }
#if MEGA
    if (hipFuncSetAttribute((const void*)fwd_kernel, hipFuncAttributeMaxDynamicSharedMemorySize, LDS_BYTES) != hipSuccess) { fprintf(stderr, "kernel_launch: LDS attribute failed\n"); return; }
#endif
    int dev = 0, cus = 0;
    (void)hipGetDevice(&dev);
    (void)hipDeviceGetAttribute(&cus, hipDeviceAttributeMultiprocessorCount, dev);
#if MEGA
    int per_cu = 0;
    (void)hipOccupancyMaxActiveBlocksPerMultiprocessor(&per_cu, fwd_kernel, NTHREADS, LDS_BYTES);
    if (per_cu < 1) { fprintf(stderr, "kernel_launch: occupancy query returned %d\n", per_cu); return; }
#endif
    if (cus < 32) { fprintf(stderr, "kernel_launch: too few CUs\n"); return; }
    grid_blocks = cus;
  }
  Params p{};
  const float* const* in = (const float* const*)d_in;
  p.x = in[0]; p.c = in[1]; p.ctx = in[2]; p.c_ctx = in[3];
  p.ada_w[0] = in[4]; p.ada_b[0] = in[5]; p.norm1[0] = in[6]; p.w_in[0] = in[7];
  p.mla_q_norm = in[8]; p.mla_w_uq = in[9]; p.mla_kv_norm = in[10]; p.mla_w_ukv = in[11];
  p.ml_conv = in[12]; p.ml_gate_b = in[13]; p.ml_head_norm = in[14];
  p.w_out[0] = in[15]; p.norm2[0] = in[16]; p.w1[0] = in[17]; p.w2[0] = in[18];
  p.ada_w[1] = in[19]; p.ada_b[1] = in[20]; p.norm1[1] = in[21]; p.w_in[1] = in[22];
  p.q_norm1 = in[23]; p.k_norm1 = in[24]; p.w_out[1] = in[25]; p.norm2[1] = in[26]; p.w1[1] = in[27]; p.w2[1] = in[28];
  p.final_norm = in[29];
  p.out = (float*)d_out; p.ws = (char*)d_ws;
#if MEGA
  (void)hipMemsetAsync((char*)d_ws + WS_BAR, 0, 256 + 3456 * 4, stream);
  void* args[] = {&p};
  hipError_t e = hipLaunchCooperativeKernel((const void*)fwd_kernel, dim3(grid_blocks), dim3(NTHREADS), args, LDS_BYTES, stream);
  if (e != hipSuccess) fprintf(stderr, "cooperative launch failed: %s (grid %d)\n", hipGetErrorString(e), grid_blocks);
#else
  const int g = grid_blocks;
  launch_phase<0>(p, g, stream); launch_phase<1>(p, g, stream); launch_phase<2>(p, g, stream); launch_phase<3>(p, g, stream);
  launch_phase<4>(p, g, stream); launch_phase<5>(p, g, stream); launch_phase<6>(p, g, stream); launch_phase<7>(p, g, stream);
  launch_phase<8>(p, g, stream); launch_phase<9>(p, g, stream); launch_phase<10>(p, g, stream); launch_phase<11>(p, g, stream);
  launch_phase<12>(p, g, stream); launch_phase<13>(p, g, stream); launch_phase<14>(p, g, stream); launch_phase<15>(p, g, stream);
  launch_phase<16>(p, g, stream); launch_phase<17>(p, g, stream); launch_phase<18>(p, g, stream); launch_phase<19>(p, g, stream);
  launch_phase<20>(p, g, stream);
#endif
}
```

```cpp
#include <hip/hip_runtime.h>
#include <hip/hip_cooperative_groups.h>
#include <cstdio>
namespace cg = cooperative_groups;

#ifndef MEGA
#define MEGA 1
#endif

typedef unsigned short bf16_t;
using bf16x8 = __attribute__((ext_vector_type(8))) short;
using s16x4  = __attribute__((ext_vector_type(4))) short;
using f32x16 = __attribute__((ext_vector_type(16))) float;
using u32x4  = __attribute__((ext_vector_type(4))) unsigned;
using u32x2  = __attribute__((ext_vector_type(2))) unsigned;
#define LAS __attribute__((address_space(3)))
typedef LAS char* LP;

constexpr int DM = 1024, NB = 4, SEQ = 8192, CTXL = 256, TPB = SEQ + CTXL, R = NB * TPB, DFF = 4096;
constexpr int P0W = 2464;
constexpr int NTHREADS = 512;
constexpr int LDS_BYTES = 135168 + 256;
constexpr int NPHASE = 21;
constexpr float EPS = 1e-6f;

constexpr size_t al256(size_t x) { return (x + 255) / 256 * 256; }
constexpr size_t WS_WT0_IN  = 0;
constexpr size_t WS_WT0_UQ  = WS_WT0_IN  + al256((size_t)2560 * 1024 * 2);
constexpr size_t WS_WT0_UKV = WS_WT0_UQ  + al256((size_t)768 * 256 * 2);
constexpr size_t WS_WT0_OUT = WS_WT0_UKV + al256((size_t)1024 * 128 * 2);
constexpr size_t WS_WT0_W1  = WS_WT0_OUT + al256((size_t)1024 * 1024 * 2);
constexpr size_t WS_WT0_W2  = WS_WT0_W1  + al256((size_t)4096 * 1024 * 2);
constexpr size_t WS_WT1_IN  = WS_WT0_W2  + al256((size_t)1024 * 4096 * 2);
constexpr size_t WS_WT1_OUT = WS_WT1_IN  + al256((size_t)1536 * 1024 * 2);
constexpr size_t WS_WT1_W1  = WS_WT1_OUT + al256((size_t)1024 * 1024 * 2);
constexpr size_t WS_WT1_W2  = WS_WT1_W1  + al256((size_t)4096 * 1024 * 2);
constexpr size_t WS_MODS    = WS_WT1_W2  + al256((size_t)1024 * 4096 * 2);
constexpr size_t WS_PART    = WS_MODS    + al256((size_t)2 * 5 * 6144 * 4);
constexpr size_t WS_ROPEM   = WS_PART    + al256((size_t)2 * 32 * 5 * 6144 * 4);
constexpr size_t WS_ROPEG   = WS_ROPEM   + al256((size_t)128 * 8 * 8);
constexpr size_t WS_SCTX    = WS_ROPEG   + al256((size_t)128 * 32 * 8);
constexpr size_t WS_GATES   = WS_SCTX    + al256((size_t)NB * CTXL * DM * 4);
constexpr size_t WS_H       = WS_GATES   + al256((size_t)R * 16 * 4);
constexpr size_t WS_BIG     = WS_H       + al256((size_t)R * 1024 * 2);
constexpr size_t WS_P0      = WS_BIG;
constexpr size_t WS_KV      = WS_P0   + al256((size_t)R * P0W * 2);
constexpr size_t WS_QM      = WS_KV   + al256((size_t)R * 1024 * 2);
constexpr size_t WS_CQN     = WS_QM   + al256((size_t)R * 768 * 2);
constexpr size_t WS_CKVN    = WS_CQN  + al256((size_t)R * 256 * 2);
constexpr size_t WS_KPE     = WS_CKVN + al256((size_t)R * 128 * 2);
constexpr size_t WS_HF      = WS_KPE  + al256((size_t)R * 32 * 2);
constexpr size_t WS_HB      = WS_HF   + al256((size_t)R * 512 * 2);
constexpr size_t WS_SCAL    = WS_HB   + al256((size_t)R * 512 * 2);
constexpr size_t WS_DEC     = WS_SCAL + al256((size_t)32 * TPB * 16);
constexpr size_t WS_CTR     = WS_DEC  + al256((size_t)32 * 66 * 4);
constexpr size_t WS_BAR     = WS_CTR  + 256;
constexpr size_t WS_XBAR    = WS_BAR  + 256;
constexpr size_t WS_END0    = WS_XBAR + al256((size_t)3456 * 4);
constexpr size_t WS_U       = WS_BIG;
constexpr size_t WS_QKV1    = WS_BIG;
constexpr size_t WS_END1    = WS_U + al256((size_t)R * 4096 * 2);
constexpr size_t WS_NEED    = WS_END0 > WS_END1 ? WS_END0 : WS_END1;

struct Params {
  const float *x, *c, *ctx, *c_ctx;
  const float *ada_w[2], *ada_b[2], *norm1[2], *w_in[2], *w_out[2], *norm2[2], *w1[2], *w2[2];
  const float *mla_q_norm, *mla_w_uq, *mla_kv_norm, *mla_w_ukv, *ml_conv, *ml_gate_b, *ml_head_norm;
  const float *q_norm1, *k_norm1, *final_norm;
  float* out;
  char* ws;
};

__device__ __forceinline__ int my_tid() { int t = threadIdx.x; asm volatile("" : "+v"(t)); return t; }
__device__ __forceinline__ float bf2f(bf16_t b) { return __uint_as_float(((unsigned)b) << 16); }
__device__ __forceinline__ unsigned cvtpk(float lo, float hi) {
  unsigned r; asm volatile("v_cvt_pk_bf16_f32 %0, %1, %2" : "=v"(r) : "v"(lo), "v"(hi)); return r;
}
__device__ __forceinline__ bf16_t f2bf(float x) { return (bf16_t)(cvtpk(x, 0.f) & 0xffffu); }
__device__ __forceinline__ int crow(int r, int hi) { return (r & 3) + 8 * (r >> 2) + 4 * hi; }
__device__ __forceinline__ float wave_sum(float v) {
#pragma unroll
  for (int o = 32; o >= 1; o >>= 1) v += __shfl_xor(v, o);
  return v;
}
__device__ __forceinline__ float siluf(float v) { return v / (1.f + __expf(-v)); }
__device__ __forceinline__ float sigmoidf(float v) { return 1.f / (1.f + __expf(-v)); }

__device__ __forceinline__ const float* in_row(const Params& p, int r) {
  const int b = r / TPB, tt = r - b * TPB;
  return tt < CTXL ? p.ctx + ((size_t)b * CTXL + tt) * DM : p.x + ((size_t)b * SEQ + (tt - CTXL)) * DM;
}
__device__ __forceinline__ float* s_row(const Params& p, int r) {
  const int b = r / TPB, tt = r - b * TPB;
  return tt < CTXL ? (float*)(p.ws + WS_SCTX) + ((size_t)b * CTXL + tt) * DM : p.out + ((size_t)b * SEQ + (tt - CTXL)) * DM;
}
__device__ __forceinline__ int mod_idx(int r) { const int b = r / TPB, tt = r - b * TPB; return tt < CTXL ? 4 : b; }
__device__ __forceinline__ int tile_row_all(int mt) { return mt * 256; }
__device__ __forceinline__ int tile_row_x(int i) { return (i >> 5) * TPB + CTXL + (i & 31) * 256; }

template <class Epi>
__device__ __forceinline__ void gemm256(const bf16_t* __restrict__ A, int lda, const bf16_t* __restrict__ Bt, int ldb, int K,
                                        LP lds, const Epi& epi) {
  const int tid = my_tid(), wid = tid >> 6, lane = tid & 63, r32 = lane & 31, hi = lane >> 5, wr = wid >> 2, wc = wid & 3;
  f32x16 acc[4][2];
#pragma unroll
  for (int i = 0; i < 4; ++i)
#pragma unroll
    for (int j = 0; j < 2; ++j) acc[i][j] = f32x16{};
  const int srow = tid >> 3, cso = ((tid & 7) ^ ((tid >> 4) & 7)) * 8;
  const bf16_t* Ag = A + (size_t)srow * lda + cso;
  const bf16_t* Bg = Bt + (size_t)srow * ldb + cso;
  const int nk = K >> 6;
#define STAGE(buf, kt) do { _Pragma("unroll") for (int i_ = 0; i_ < 4; ++i_) { \
    __builtin_amdgcn_global_load_lds((const unsigned*)(Ag + (size_t)(i_ * 64) * lda + (kt) * 64), (LAS unsigned*)(lds + (buf) * 65536 + (i_ * 512 + wid * 64) * 16), 16, 0, 0); \
    __builtin_amdgcn_global_load_lds((const unsigned*)(Bg + (size_t)(i_ * 64) * ldb + (kt) * 64), (LAS unsigned*)(lds + (buf) * 65536 + 32768 + (i_ * 512 + wid * 64) * 16), 16, 0, 0); } } while (0)
  const int swz = (r32 >> 1) & 7;
  const int aoff = (wr * 128 + r32) * 128, boff = 32768 + (wc * 64 + r32) * 128;
  __syncthreads();
  STAGE(0, 0);
  __syncthreads();
#define LOADF(F, G, kk) do { const int so_ = (((kk) * 2 + hi) ^ swz) << 4; \
    _Pragma("unroll") for (int i_ = 0; i_ < 4; ++i_) F[i_] = *reinterpret_cast<const LAS bf16x8*>(base + aoff + i_ * 4096 + so_); \
    _Pragma("unroll") for (int j_ = 0; j_ < 2; ++j_) G[j_] = *reinterpret_cast<const LAS bf16x8*>(base + boff + j_ * 4096 + so_); } while (0)
#define MMA(F, G) do { _Pragma("unroll") for (int i_ = 0; i_ < 4; ++i_) _Pragma("unroll") for (int j_ = 0; j_ < 2; ++j_) \
    acc[i_][j_] = __builtin_amdgcn_mfma_f32_32x32x16_bf16(F[i_], G[j_], acc[i_][j_], 0, 0, 0); } while (0)
  for (int kt = 0; kt < nk; ++kt) {
    if (kt + 1 < nk) STAGE((kt + 1) & 1, kt + 1);
    const LP base = lds + (kt & 1) * 65536;
    bf16x8 a0[4], b0[2], a1[4], b1[2];
    LOADF(a0, b0, 0); __builtin_amdgcn_sched_barrier(0);
    LOADF(a1, b1, 1); MMA(a0, b0); __builtin_amdgcn_sched_barrier(0);
    LOADF(a0, b0, 2); MMA(a1, b1); __builtin_amdgcn_sched_barrier(0);
    LOADF(a1, b1, 3); MMA(a0, b0); __builtin_amdgcn_sched_barrier(0);
    MMA(a1, b1);
    __syncthreads();
  }
#undef LOADF
#undef MMA
#undef STAGE
  int e_rr = wr * 128, e_cc = wc * 64 + r32, e_hi = hi;
  asm volatile("" : "+v"(e_rr), "+v"(e_cc), "+v"(e_hi));
#pragma unroll
  for (int i = 0; i < 4; ++i)
#pragma unroll
    for (int j = 0; j < 2; ++j) { __builtin_amdgcn_sched_barrier(0); epi(e_rr + i * 32, e_cc + j * 32, e_hi, acc[i][j]); }
  __builtin_amdgcn_sched_barrier(0);
}

template <class Epi>
__device__ __forceinline__ void gemm8p(const bf16_t* __restrict__ A, int lda, const bf16_t* __restrict__ Bt, int ldb, int K,
                                       LP lds, const Epi& epi, bool pre = false, const bf16_t* An = nullptr, const bf16_t* Bn = nullptr) {
  const int tid = my_tid(), wid = tid >> 6, lane = tid & 63, r32 = lane & 31, hi = lane >> 5, wr = wid >> 2, wc = wid & 3;
  f32x16 acc[2][2][2];
#pragma unroll
  for (int a = 0; a < 2; ++a)
#pragma unroll
    for (int b = 0; b < 2; ++b) { acc[a][b][0] = f32x16{}; acc[a][b][1] = f32x16{}; }
  bf16x8 At[2][4], B0[4], B1[4];
  const int srow = tid >> 3, cso = ((tid & 7) ^ ((tid >> 4) & 7)) * 8;
  const bf16_t* Ag = A + (size_t)srow * lda + cso;
  const bf16_t* Bg = Bt + (size_t)srow * ldb + cso;
  const int swz = (r32 >> 1) & 7;
  const LP la = lds + (wr * 64 + r32) * 128, lb = lds + 65536 + (wc * 32 + r32) * 128;
  const LP lw = lds + wid * 1024;
#define G8_SA(b, h) (((b) * 2 + (h)) * 16384)
#define G8_SB(b, h) (65536 + ((b) * 2 + (h)) * 16384)
#define G8_STAGE(P, G, ld, h, kt) do { _Pragma("unroll") for (int i_ = 0; i_ < 2; ++i_) \
    __builtin_amdgcn_global_load_lds((const unsigned*)(G + (size_t)((h) * 128 + i_ * 64) * (ld) + (size_t)(kt) * 64), (LAS unsigned*)(lw + (P) + i_ * 8192), 16, 0, 0); } while (0)
#define G8_STA(b, h, kt) G8_STAGE(G8_SA(b, h), Ag, lda, h, kt)
#define G8_STB(b, h, kt) G8_STAGE(G8_SB(b, h), Bg, ldb, h, kt)
#define G8_LDA(b, h) do { _Pragma("unroll") for (int m_ = 0; m_ < 2; ++m_) _Pragma("unroll") for (int k_ = 0; k_ < 4; ++k_) \
    At[m_][k_] = *reinterpret_cast<const LAS bf16x8*>(la + ((b) * 2 + (h)) * 16384 + m_ * 4096 + (((k_ * 2 + hi) ^ swz) << 4)); } while (0)
#define G8_LDB(dst, b, h) do { _Pragma("unroll") for (int k_ = 0; k_ < 4; ++k_) \
    dst[k_] = *reinterpret_cast<const LAS bf16x8*>(lb + ((b) * 2 + (h)) * 16384 + (((k_ * 2 + hi) ^ swz) << 4)); } while (0)
#define G8_MMA(ai, bj, Bx) do { __builtin_amdgcn_s_setprio(1); _Pragma("unroll") for (int k_ = 0; k_ < 4; ++k_) _Pragma("unroll") for (int m_ = 0; m_ < 2; ++m_) \
    acc[ai][bj][m_] = __builtin_amdgcn_mfma_f32_32x32x16_bf16(At[m_][k_], Bx[k_], acc[ai][bj][m_], 0, 0, 0); __builtin_amdgcn_s_setprio(0); } while (0)
#define G8_WV(n) asm volatile("s_waitcnt vmcnt(" #n ")" ::: "memory")
#define G8_WL(n) asm volatile("s_waitcnt lgkmcnt(" #n ")" ::: "memory")
#define G8_BAR __builtin_amdgcn_s_barrier()
#define G8_SCHED __builtin_amdgcn_sched_barrier(0)
  const int nt = K >> 6;
  __syncthreads();
  G8_SCHED;
  if (!pre) { G8_STB(0, 0, 0); G8_STA(0, 0, 0); G8_STB(0, 1, 0); G8_STA(0, 1, 0); }
  if (wr == 1) G8_BAR;
  G8_WV(4); G8_BAR;
  G8_STB(1, 0, 1); G8_STA(1, 0, 1); G8_STB(1, 1, 1);
  G8_WV(6); G8_BAR;
  G8_SCHED;
  for (int t = 0; t < nt - 2; t += 2) {
    G8_LDB(B0, 0, 0); G8_SCHED; G8_LDA(0, 0); G8_STA(1, 1, t + 1);
    G8_WL(8); G8_BAR; G8_WL(0); G8_MMA(0, 0, B0); G8_BAR; G8_SCHED;
    G8_LDB(B1, 0, 1); G8_STB(0, 0, t + 2);
    G8_BAR; G8_WL(0); G8_MMA(0, 1, B1); G8_BAR; G8_SCHED;
    G8_LDA(0, 1); G8_STA(0, 0, t + 2);
    G8_BAR; G8_WL(0); G8_MMA(1, 0, B0); G8_BAR; G8_SCHED;
    G8_STB(0, 1, t + 2);
    G8_WV(6); G8_BAR; G8_MMA(1, 1, B1); G8_BAR; G8_SCHED;
    G8_LDB(B0, 1, 0); G8_SCHED; G8_LDA(1, 0); G8_STA(0, 1, t + 2);
    G8_WL(8); G8_BAR; G8_WL(0); G8_MMA(0, 0, B0); G8_BAR; G8_SCHED;
    G8_LDB(B1, 1, 1); G8_STB(1, 0, t + 3);
    G8_BAR; G8_WL(0); G8_MMA(0, 1, B1); G8_BAR; G8_SCHED;
    G8_LDA(1, 1); G8_STA(1, 0, t + 3);
    G8_BAR; G8_WL(0); G8_MMA(1, 0, B0); G8_BAR; G8_SCHED;
    G8_STB(1, 1, t + 3);
    G8_WV(6); G8_BAR; G8_MMA(1, 1, B1); G8_BAR; G8_SCHED;
  }
  { G8_LDB(B0, 0, 0); G8_LDA(0, 0); G8_STA(1, 1, nt - 1);
    G8_BAR; G8_WL(0); G8_MMA(0, 0, B0); G8_BAR; G8_SCHED;
    G8_LDB(B1, 0, 1); G8_BAR; G8_WL(0); G8_MMA(0, 1, B1); G8_BAR; G8_SCHED;
    G8_LDA(0, 1); G8_WV(4); G8_BAR; G8_WL(0); G8_MMA(1, 0, B0); G8_MMA(1, 1, B1); G8_BAR; G8_SCHED; }
  { G8_LDB(B0, 1, 0); G8_LDA(1, 0); G8_WV(2); G8_BAR; G8_WL(0); G8_MMA(0, 0, B0); G8_BAR; G8_SCHED;
    G8_LDB(B1, 1, 1); G8_WV(0); G8_BAR; G8_WL(0); G8_MMA(0, 1, B1); G8_BAR; G8_SCHED;
    G8_LDA(1, 1); G8_BAR; G8_WL(0); G8_MMA(1, 0, B0); G8_MMA(1, 1, B1); G8_BAR; G8_SCHED; }
  if (wr == 0) G8_BAR;
  G8_SCHED;
  if (An != nullptr) {
    const bf16_t* Ag2 = An + (size_t)srow * lda + cso; const bf16_t* Bg2 = Bn + (size_t)srow * ldb + cso;
    G8_STAGE(G8_SB(0, 0), Bg2, ldb, 0, 0); G8_STAGE(G8_SA(0, 0), Ag2, lda, 0, 0); G8_STAGE(G8_SB(0, 1), Bg2, ldb, 1, 0); G8_STAGE(G8_SA(0, 1), Ag2, lda, 1, 0);
  }
  G8_SCHED;
#undef G8_SA
#undef G8_SB
#undef G8_STAGE
#undef G8_STA
#undef G8_STB
#undef G8_LDA
#undef G8_LDB
#undef G8_MMA
#undef G8_WV
#undef G8_WL
#undef G8_BAR
#undef G8_SCHED
  int e_rr = wr * 64, e_cc = wc * 32 + r32, e_hi = hi;
  asm volatile("" : "+v"(e_rr), "+v"(e_cc), "+v"(e_hi));
#pragma unroll
  for (int a = 0; a < 2; ++a)
#pragma unroll
    for (int b = 0; b < 2; ++b)
#pragma unroll
      for (int m = 0; m < 2; ++m) { __builtin_amdgcn_sched_barrier(0); epi(a * 128 + e_rr + m * 32, b * 128 + e_cc, e_hi, acc[a][b][m]); }
  __builtin_amdgcn_sched_barrier(0);
}

#define KSWZ(row, colB) ((row) * 256 + ((colB) ^ (((row) & 7) << 4)))
#define SBAR() __builtin_amdgcn_sched_barrier(0)
constexpr int SHM_V = 64 * 128 * 2, SHM_K = 64 * 128 * 2;

__device__ __forceinline__ void partialSM(f32x16& p0, f32x16& p1, float& m_reg, float& mn, float& alpha, float C, float thr) {
  float pmax = p0[0];
#pragma unroll
  for (int r = 1; r < 16; ++r) pmax = fmaxf(pmax, p0[r]);
#pragma unroll
  for (int r = 0; r < 16; ++r) pmax = fmaxf(pmax, p1[r]);
  { auto rr = __builtin_amdgcn_permlane32_swap(__float_as_uint(pmax), __float_as_uint(pmax), false, false);
    pmax = fmaxf(__uint_as_float(rr[0]), __uint_as_float(rr[1])); }
  if (__builtin_expect(__all(pmax - m_reg <= thr), 1)) { mn = m_reg; alpha = 1.f; }
  else { mn = fmaxf(m_reg, pmax); alpha = __builtin_amdgcn_exp2f((m_reg - mn) * C); m_reg = mn; }
  const float mnC = -mn * C;
#pragma unroll
  for (int r = 0; r < 16; ++r) p0[r] = fmaf(p0[r], C, mnC);
#pragma unroll
  for (int r = 0; r < 16; ++r) p1[r] = fmaf(p1[r], C, mnC);
#pragma unroll
  for (int r = 0; r < 16; ++r) p0[r] = __builtin_amdgcn_exp2f(p0[r]);
}
__device__ __forceinline__ void finishSM(f32x16& p0, f32x16& p1, float alpha, float& l_reg, bf16x8& pa0, bf16x8& pa1, bf16x8& pa2, bf16x8& pa3) {
#pragma unroll
  for (int r = 0; r < 16; ++r) p1[r] = __builtin_amdgcn_exp2f(p1[r]);
  float ps = 0;
#pragma unroll
  for (int r = 0; r < 16; ++r) ps += p0[r];
#pragma unroll
  for (int r = 0; r < 16; ++r) ps += p1[r];
  { auto rr = __builtin_amdgcn_permlane32_swap(__float_as_uint(ps), __float_as_uint(ps), false, false);
    ps = __uint_as_float(rr[0]) + __uint_as_float(rr[1]); }
  l_reg = l_reg * alpha + ps;
#define PK4(P, BASE, OUT) do { unsigned a0 = cvtpk(P[BASE + 0], P[BASE + 1]), a1 = cvtpk(P[BASE + 2], P[BASE + 3]);   \
    unsigned b0 = cvtpk(P[BASE + 4], P[BASE + 5]), b1 = cvtpk(P[BASE + 6], P[BASE + 7]);                              \
    auto r0 = __builtin_amdgcn_permlane32_swap(a0, b0, false, false); auto r1 = __builtin_amdgcn_permlane32_swap(a1, b1, false, false); \
    u32x4 w = {r0[0], r1[0], r0[1], r1[1]}; OUT = *reinterpret_cast<bf16x8*>(&w); } while (0)
  PK4(p0, 0, pa0); PK4(p0, 8, pa1); PK4(p1, 0, pa2); PK4(p1, 8, pa3);
#undef PK4
}
template <int NDQ>
__device__ __forceinline__ void qkt(f32x16& p0, f32x16& p1, const LAS char* Ks, const bf16x8* qr, int r32, int hi) {
  p0 = f32x16{}; p1 = f32x16{};
#pragma unroll
  for (int d0 = 0; d0 < NDQ; ++d0) { const int cb = (d0 * 16 + hi * 8) * 2;
    bf16x8 b0 = *reinterpret_cast<const LAS bf16x8*>(Ks + KSWZ(r32, cb));
    bf16x8 b1 = *reinterpret_cast<const LAS bf16x8*>(Ks + KSWZ(32 + r32, cb));
    p0 = __builtin_amdgcn_mfma_f32_32x32x16_bf16(b0, qr[d0], p0, 0, 0, 0);
    p1 = __builtin_amdgcn_mfma_f32_32x32x16_bf16(b1, qr[d0], p1, 0, 0, 0); }
}
__device__ __forceinline__ int v_st(int k, int c) { const int kk = (k & ~0xC) | ((k & 4) << 1) | ((k & 8) >> 1); return ((kk >> 3) * 4 + (c >> 5)) * 512 + ((kk & 7) * 32 + (c & 31)) * 2; }
__device__ __forceinline__ int v_rd_base(int lane) { return ((lane & 3) << 3) | (((lane >> 2) & 3) << 6) | (((lane >> 4) & 1) << 5) | (((lane >> 5) & 1) << 8); }
constexpr int v_rd_off(int d0, int ks, int half) { return d0 * 512 + ks * 4096 + half * 2048; }
template <int OFF> __device__ __forceinline__ s16x4 tr_read(int vb) {
  s16x4 r; asm volatile("ds_read_b64_tr_b16 %0, %1 offset:%2" : "=&v"(r) : "v"(vb), "i"(OFF) : "memory"); return r;
}
template <int D0> __device__ __forceinline__ void pv_one(f32x16& od, int vb, bf16x8 pa0, bf16x8 pa1, bf16x8 pa2, bf16x8 pa3) {
  const s16x4 l0 = tr_read<v_rd_off(D0, 0, 0)>(vb), h0 = tr_read<v_rd_off(D0, 0, 1)>(vb), l1 = tr_read<v_rd_off(D0, 1, 0)>(vb), h1 = tr_read<v_rd_off(D0, 1, 1)>(vb);
  const s16x4 l2 = tr_read<v_rd_off(D0, 2, 0)>(vb), h2 = tr_read<v_rd_off(D0, 2, 1)>(vb), l3 = tr_read<v_rd_off(D0, 3, 0)>(vb), h3 = tr_read<v_rd_off(D0, 3, 1)>(vb);
  asm volatile("s_waitcnt lgkmcnt(0)" ::: "memory"); SBAR();
#define PK(L, H) (bf16x8){L[0], L[1], L[2], L[3], H[0], H[1], H[2], H[3]}
  od = __builtin_amdgcn_mfma_f32_32x32x16_bf16(pa0, PK(l0, h0), od, 0, 0, 0);
  od = __builtin_amdgcn_mfma_f32_32x32x16_bf16(pa1, PK(l1, h1), od, 0, 0, 0);
  od = __builtin_amdgcn_mfma_f32_32x32x16_bf16(pa2, PK(l2, h2), od, 0, 0, 0);
  od = __builtin_amdgcn_mfma_f32_32x32x16_bf16(pa3, PK(l3, h3), od, 0, 0, 0);
#undef PK
}
template <int NDV>
__device__ __forceinline__ void pv_d0(f32x16* o, int vb, bf16x8 pa0, bf16x8 pa1, bf16x8 pa2, bf16x8 pa3) {
  pv_one<0>(o[0], vb, pa0, pa1, pa2, pa3); pv_one<1>(o[1], vb, pa0, pa1, pa2, pa3);
  if constexpr (NDV == 4) { pv_one<2>(o[2], vb, pa0, pa1, pa2, pa3); pv_one<3>(o[3], vb, pa0, pa1, pa2, pa3); }
}

template <int NDQ, int NDV>
__device__ __forceinline__ void attn_body(const bf16_t* __restrict__ Qb, int ldq, const bf16_t* __restrict__ kptr, int kstr,
                                          const bf16_t* __restrict__ vptr, int vstr, bf16_t* __restrict__ Ob, int ldo, int seq,
                                          float Cs, float thr, LP lds) {
  const int tid = my_tid(), wid = tid >> 6, lane = tid & 63, r32 = lane & 31, hi = lane >> 5;
  LP V_lds = lds; LP K_lds = lds + 2 * SHM_V;
  LAS float* wsx = (LAS float*)(lds + 2 * SHM_V + 2 * SHM_K) + wid * 64; LAS float* li_l = wsx; LAS float* al_l = wsx + 32;
  float m_reg = -1e30f, l_reg = 0; f32x16 o[NDV]; bf16x8 qr[NDQ];
#pragma unroll
  for (int d = 0; d < NDV; ++d) o[d] = f32x16{};
  const bf16_t* Qw = Qb + (size_t)(wid * 32 + r32) * ldq + hi * 8;
#pragma unroll
  for (int d0 = 0; d0 < NDQ; ++d0) qr[d0] = *reinterpret_cast<const bf16x8*>(Qw + d0 * 16);
  const int sr = tid >> 4, sc = (tid & 15) * 8, vst0 = v_st(sr, sc), vst1 = v_st(32 + sr, sc);
  const int vb0 = (int)(unsigned)(size_t)V_lds + v_rd_base(lane);
  struct { bf16x8 vs0, vs1, ks0, ks1; } sr_[2];
#define SLOAD(i, k0) do { sr_[i].vs0 = *reinterpret_cast<const bf16x8*>(vptr + (size_t)((k0) + sr) * vstr); \
    sr_[i].vs1 = *reinterpret_cast<const bf16x8*>(vptr + (size_t)((k0) + 32 + sr) * vstr); \
    sr_[i].ks0 = *reinterpret_cast<const bf16x8*>(kptr + (size_t)((k0) + sr) * kstr); \
    sr_[i].ks1 = *reinterpret_cast<const bf16x8*>(kptr + (size_t)((k0) + 32 + sr) * kstr); } while (0)
#define SWRITE(b, i) do { *(LAS bf16x8*)(V_lds + (b) * SHM_V + vst0) = sr_[i].vs0;          \
    *(LAS bf16x8*)(V_lds + (b) * SHM_V + vst1) = sr_[i].vs1; const int kc = sc * 2;               \
    *(LAS bf16x8*)(K_lds + (b) * SHM_K + KSWZ(sr, kc)) = sr_[i].ks0;                       \
    *(LAS bf16x8*)(K_lds + (b) * SHM_K + KSWZ(32 + sr, kc)) = sr_[i].ks1; } while (0)
#define SWAIT() asm volatile("s_waitcnt vmcnt(4)" ::: "memory")
#define RESC(a) do { if (__any((a) < 1.f)) { if (hi == 0) al_l[r32] = (a); asm volatile("s_waitcnt lgkmcnt(0)" ::: "memory"); \
    _Pragma("unroll") for (int d = 0; d < NDV; ++d) _Pragma("unroll") for (int r = 0; r < 16; ++r) o[d][r] *= al_l[crow(r, hi)]; } } while (0)
  f32x16 pA0, pA1, pB0, pB1; float mnA, mnB, alA, alB; bf16x8 pa0, pa1, pa2, pa3; const int NT = seq / 64;
  constexpr int SE = 0, SO = 1;
  __syncthreads();
  SLOAD(SE, 0); asm volatile("s_waitcnt vmcnt(0)" ::: "memory"); SWRITE(0, SE); __syncthreads();
  qkt<NDQ>(pA0, pA1, K_lds, qr, r32, hi); partialSM(pA0, pA1, m_reg, mnA, alA, Cs, thr);
  SLOAD(SO, 64); if (2 < NT) SLOAD(SE, 128);
  SWAIT(); SWRITE(1, SO); __syncthreads();
  for (int j = 1; j + 1 < NT; j += 2) {
    SBAR(); qkt<NDQ>(pB0, pB1, K_lds + SHM_K, qr, r32, hi);
    finishSM(pA0, pA1, alA, l_reg, pa0, pa1, pa2, pa3); SBAR();
    SLOAD(SO, (j + 2) * 64); SBAR();
    pv_d0<NDV>(o, vb0, pa0, pa1, pa2, pa3); partialSM(pB0, pB1, m_reg, mnB, alB, Cs, thr);
    __syncthreads(); SWAIT(); SWRITE(0, SE);
    RESC(alB); __syncthreads();
    SBAR(); qkt<NDQ>(pA0, pA1, K_lds, qr, r32, hi);
    finishSM(pB0, pB1, alB, l_reg, pa0, pa1, pa2, pa3); SBAR();
    if (j + 3 < NT) SLOAD(SE, (j + 3) * 64); SBAR();
    pv_d0<NDV>(o, vb0 + SHM_V, pa0, pa1, pa2, pa3); partialSM(pA0, pA1, m_reg, mnA, alA, Cs, thr);
    __syncthreads(); SWAIT(); SWRITE(1, SO);
    RESC(alA); __syncthreads();
  }
  SBAR(); qkt<NDQ>(pB0, pB1, K_lds + SHM_K, qr, r32, hi);
  finishSM(pA0, pA1, alA, l_reg, pa0, pa1, pa2, pa3); SBAR();
  pv_d0<NDV>(o, vb0, pa0, pa1, pa2, pa3); partialSM(pB0, pB1, m_reg, mnB, alB, Cs, thr);
  __syncthreads(); RESC(alB);
  finishSM(pB0, pB1, alB, l_reg, pa0, pa1, pa2, pa3); SBAR();
  pv_d0<NDV>(o, vb0 + SHM_V, pa0, pa1, pa2, pa3);
  if (hi == 0) li_l[r32] = l_reg; asm volatile("s_waitcnt lgkmcnt(0)" ::: "memory");
  float rli[16];
#pragma unroll
  for (int r = 0; r < 16; ++r) rli[r] = __builtin_amdgcn_rcpf(li_l[crow(r, hi)]);
  bf16_t* Ow = Ob + (size_t)(wid * 32) * ldo;
#pragma unroll
  for (int r = 0; r < 16; ++r) { const int orow = crow(r, hi);
#pragma unroll
    for (int d0 = 0; d0 < NDV; ++d0) Ow[(size_t)orow * ldo + d0 * 32 + r32] = f2bf(o[d0][r] * rli[r]); }
#undef SLOAD
#undef SWRITE
#undef SWAIT
#undef RESC
}

__device__ __forceinline__ void convert_T(const float* __restrict__ W, int K, int N, int Npad, bf16_t* __restrict__ WT, LP lds) {
  LAS float* tile = (LAS float*)lds;
  const int tid = my_tid();
  const int tn = Npad / 64, ntile = (K / 64) * tn;
  for (int t = blockIdx.x; t < ntile; t += gridDim.x) {
    const int k0 = (t / tn) * 64, n0 = (t % tn) * 64;
    __syncthreads();
    { const int kr = tid >> 4, nc = (tid & 15) * 4;
#pragma unroll
      for (int i = 0; i < 2; ++i) {
        float4 v = make_float4(0.f, 0.f, 0.f, 0.f);
        if (n0 + nc < N) v = *reinterpret_cast<const float4*>(W + (size_t)(k0 + kr + i * 32) * N + n0 + nc);
        LAS float* d = tile + (kr + i * 32) * 65 + nc; d[0] = v.x; d[1] = v.y; d[2] = v.z; d[3] = v.w;
      } }
    __syncthreads();
    { const int nr = tid >> 3, kc = (tid & 7) * 8;
      u32x4 w;
      w[0] = cvtpk(tile[(kc + 0) * 65 + nr], tile[(kc + 1) * 65 + nr]); w[1] = cvtpk(tile[(kc + 2) * 65 + nr], tile[(kc + 3) * 65 + nr]);
      w[2] = cvtpk(tile[(kc + 4) * 65 + nr], tile[(kc + 5) * 65 + nr]); w[3] = cvtpk(tile[(kc + 6) * 65 + nr], tile[(kc + 7) * 65 + nr]);
      *reinterpret_cast<u32x4*>(WT + (size_t)(n0 + nr) * K + k0 + kc) = w; }
  }
}
__device__ __forceinline__ void phase_prep(const Params& p, LP lds) {
  char* ws = p.ws;
  convert_T(p.w_in[0], 1024, 2480, 2560, (bf16_t*)(ws + WS_WT0_IN), lds);
  convert_T(p.mla_w_uq, 256, 768, 768, (bf16_t*)(ws + WS_WT0_UQ), lds);
  convert_T(p.mla_w_ukv, 128, 1024, 1024, (bf16_t*)(ws + WS_WT0_UKV), lds);
  convert_T(p.w_out[0], 1024, 1024, 1024, (bf16_t*)(ws + WS_WT0_OUT), lds);
  convert_T(p.w1[0], 1024, 4096, 4096, (bf16_t*)(ws + WS_WT0_W1), lds);
  convert_T(p.w2[0], 4096, 1024, 1024, (bf16_t*)(ws + WS_WT0_W2), lds);
  convert_T(p.w_in[1], 1024, 1536, 1536, (bf16_t*)(ws + WS_WT1_IN), lds);
  convert_T(p.w_out[1], 1024, 1024, 1024, (bf16_t*)(ws + WS_WT1_OUT), lds);
  convert_T(p.w1[1], 1024, 4096, 4096, (bf16_t*)(ws + WS_WT1_W1), lds);
  convert_T(p.w2[1], 4096, 1024, 1024, (bf16_t*)(ws + WS_WT1_W2), lds);
  if (blockIdx.x == 0 && my_tid() < 64) ((int*)(ws + WS_CTR))[my_tid()] = 0;
  LAS float* sc = (LAS float*)lds; const int tid = my_tid();
  float* part = (float*)(ws + WS_PART);
  for (int it = blockIdx.x; it < 192; it += gridDim.x) {
    const int L = it / 96, rem = it % 96, ks = rem / 3, ch = rem % 3, k0 = ks * 32;
    __syncthreads();
    if (tid < 160) { const int mb = tid >> 5, kk = tid & 31; const float v = mb < 4 ? p.c[mb * 1024 + k0 + kk] : p.c_ctx[k0 + kk]; sc[tid] = v / (1.f + expf(-v)); }
    __syncthreads();
    const int n = ch * 2048 + tid * 4;
    float4 acc[5];
#pragma unroll
    for (int mb = 0; mb < 5; ++mb) acc[mb] = make_float4(0.f, 0.f, 0.f, 0.f);
    const float* wp = p.ada_w[L] + (size_t)k0 * 6144 + n;
    for (int kk = 0; kk < 32; ++kk) {
      const float4 w = *reinterpret_cast<const float4*>(wp + (size_t)kk * 6144);
#pragma unroll
      for (int mb = 0; mb < 5; ++mb) { const float s = sc[mb * 32 + kk]; acc[mb].x += s * w.x; acc[mb].y += s * w.y; acc[mb].z += s * w.z; acc[mb].w += s * w.w; }
    }
#pragma unroll
    for (int mb = 0; mb < 5; ++mb) *reinterpret_cast<float4*>(part + ((size_t)((L * 32 + ks) * 5 + mb)) * 6144 + n) = acc[mb];
  }
}
__device__ __forceinline__ void phase_mods(const Params& p) {
  char* ws = p.ws; const float* part = (const float*)(ws + WS_PART); float* mods = (float*)(ws + WS_MODS);
  const int gt = blockIdx.x * NTHREADS + my_tid(), gs = gridDim.x * NTHREADS;
  for (int i = gt; i < 2 * 5 * 6144; i += gs) {
    const int L = i / 30720, rem = i % 30720, mb = rem / 6144, n = rem % 6144;
    float s = p.ada_b[L][n];
    for (int ks = 0; ks < 32; ++ks) s += part[((size_t)((L * 32 + ks) * 5 + mb)) * 6144 + n];
    mods[i] = s;
  }
  float2* rm = (float2*)(ws + WS_ROPEM); float2* rg = (float2*)(ws + WS_ROPEG);
  for (int i = gt; i < 128 * 8 + 128 * 32; i += gs) {
    if (i < 1024) { const int pos = i >> 3, f = i & 7; const float fr = powf(10000.f, -(float)f / 8.f); const float a = (float)pos * fr; rm[i] = make_float2(cosf(a), sinf(a)); }
    else { const int k = i - 1024, pos = k >> 5, f = k & 31; const float fr = powf(10000.f, -(float)f / 32.f); const float a = (float)pos * fr; rg[k] = make_float2(cosf(a), sinf(a)); }
  }
}
__device__ __forceinline__ void phase_norm(const Params& p, int L, int which, const float* __restrict__ gain, int shift_slot, bool xonly) {
  const int lane = my_tid() & 63, gw = blockIdx.x * 8 + (my_tid() >> 6), nw = gridDim.x * 8;
  const float* mods = (const float*)(p.ws + WS_MODS) + (size_t)L * 5 * 6144;
  bf16_t* H = (bf16_t*)(p.ws + WS_H);
  for (int r = gw; r < R; r += nw) {
    const int b = r / TPB, tt = r - b * TPB;
    if (xonly && tt < CTXL) continue;
    const float* src = which == 0 ? in_row(p, r) : s_row(p, r);
    const float* md = mods + (size_t)(tt < CTXL ? 4 : b) * 6144;
    float4 v[4]; float ss = 0;
#pragma unroll
    for (int i = 0; i < 4; ++i) { v[i] = *reinterpret_cast<const float4*>(src + i * 256 + lane * 4); ss += v[i].x * v[i].x + v[i].y * v[i].y + v[i].z * v[i].z + v[i].w * v[i].w; }
    ss = wave_sum(ss);
    if (which == 0 && tt < CTXL) { float* sd = s_row(p, r);
#pragma unroll
      for (int i = 0; i < 4; ++i) *reinterpret_cast<float4*>(sd + i * 256 + lane * 4) = v[i]; }
    const float rstd = rsqrtf(ss * (1.f / 1024.f) + EPS);
#pragma unroll
    for (int i = 0; i < 4; ++i) {
      const int c = i * 256 + lane * 4;
      const float4 g = *reinterpret_cast<const float4*>(gain + c);
      const float4 sh = *reinterpret_cast<const float4*>(md + shift_slot * 1024 + c);
      const float4 scl = *reinterpret_cast<const float4*>(md + (shift_slot + 1) * 1024 + c);
      const float o0 = v[i].x * rstd * g.x * (1.f + scl.x) + sh.x, o1 = v[i].y * rstd * g.y * (1.f + scl.y) + sh.y;
      const float o2 = v[i].z * rstd * g.z * (1.f + scl.z) + sh.z, o3 = v[i].w * rstd * g.w * (1.f + scl.w) + sh.w;
      u32x2 w = {cvtpk(o0, o1), cvtpk(o2, o3)};
      *reinterpret_cast<u32x2*>(H + (size_t)r * 1024 + c) = w;
    }
  }
}
__device__ __forceinline__ void mlstm_scal(const Params& p, int chain, LP lds);
__device__ __forceinline__ void phase_prep0(const Params& p, LP lds) {
  if (blockIdx.x < 32) { mlstm_scal(p, blockIdx.x, lds); return; }
  const int lane = my_tid() & 63, gw = (blockIdx.x - 32) * 8 + (my_tid() >> 6), nw = (gridDim.x - 32) * 8;
  const bf16_t* P0 = (const bf16_t*)(p.ws + WS_P0);
  bf16_t* CQN = (bf16_t*)(p.ws + WS_CQN); bf16_t* CKVN = (bf16_t*)(p.ws + WS_CKVN); bf16_t* KPE = (bf16_t*)(p.ws + WS_KPE);
  const float2* rm = (const float2*)(p.ws + WS_ROPEM);
  bf16_t* MQ = (bf16_t*)p.out; bf16_t* MK = MQ + (size_t)R * 512;
  for (int r = gw; r < R; r += nw) {
    const int b = r / TPB, tt = r - b * TPB;
    const bf16_t* row = P0 + (size_t)r * P0W;
    {
      const int lo = tt < CTXL ? 0 : CTXL, hi_ = tt < CTXL ? CTXL : TPB;
      float aq[8], ak[8];
#pragma unroll
      for (int i = 0; i < 8; ++i) { aq[i] = 0.f; ak[i] = 0.f; }
#pragma unroll
      for (int kk = 0; kk < 3; ++kk) { const int t2 = tt + kk - 1;
        if (t2 >= lo && t2 < hi_) { const bf16_t* r2 = P0 + (size_t)(r + kk - 1) * P0W + 416 + lane * 8;
          const u32x4 qv = *reinterpret_cast<const u32x4*>(r2), kv = *reinterpret_cast<const u32x4*>(r2 + 512);
          const float* wq = p.ml_conv + kk * 1024 + lane * 8; const float* wk = wq + 512;
#pragma unroll
          for (int q = 0; q < 4; ++q) { aq[2 * q] += wq[2 * q] * __uint_as_float(qv[q] << 16); aq[2 * q + 1] += wq[2 * q + 1] * __uint_as_float(qv[q] & 0xffff0000u);
            ak[2 * q] += wk[2 * q] * __uint_as_float(kv[q] << 16); ak[2 * q + 1] += wk[2 * q + 1] * __uint_as_float(kv[q] & 0xffff0000u); } } }
      u32x4 qo, ko;
#pragma unroll
      for (int q = 0; q < 4; ++q) { qo[q] = cvtpk(siluf(aq[2 * q]) * 0.08838834764831845f, siluf(aq[2 * q + 1]) * 0.08838834764831845f); ko[q] = cvtpk(siluf(ak[2 * q]), siluf(ak[2 * q + 1])); }
      *reinterpret_cast<u32x4*>(MQ + (size_t)r * 512 + lane * 8) = qo; *reinterpret_cast<u32x4*>(MK + (size_t)r * 512 + lane * 8) = ko; }
    { const u32x2 w = *reinterpret_cast<const u32x2*>(row + lane * 4);
      const float a0 = __uint_as_float(w[0] << 16), a1 = __uint_as_float(w[0] & 0xffff0000u), a2 = __uint_as_float(w[1] << 16), a3 = __uint_as_float(w[1] & 0xffff0000u);
      const float ss = wave_sum(a0 * a0 + a1 * a1 + a2 * a2 + a3 * a3);
      const float rstd = rsqrtf(ss * (1.f / 256.f) + EPS);
      const float4 g = *reinterpret_cast<const float4*>(p.mla_q_norm + lane * 4);
      u32x2 o = {cvtpk(a0 * rstd * g.x, a1 * rstd * g.y), cvtpk(a2 * rstd * g.z, a3 * rstd * g.w)};
      *reinterpret_cast<u32x2*>(CQN + (size_t)r * 256 + lane * 4) = o; }
    { const unsigned w = *reinterpret_cast<const unsigned*>(row + 256 + lane * 2);
      const float a0 = __uint_as_float(w << 16), a1 = __uint_as_float(w & 0xffff0000u);
      const float ss = wave_sum(a0 * a0 + a1 * a1);
      const float rstd = rsqrtf(ss * (1.f / 128.f) + EPS);
      const float2 g = *reinterpret_cast<const float2*>(p.mla_kv_norm + lane * 2);
      *reinterpret_cast<unsigned*>(CKVN + (size_t)r * 128 + lane * 2) = cvtpk(a0 * rstd * g.x, a1 * rstd * g.y); }
    { const int l = lane & 31;
      const float v = bf2f(row[384 + l]);
      const float pr = __shfl_xor(v, 8);
      float o = v;
      if (tt >= CTXL) { const int t = tt - CTXL, a = l >> 4, pp = (l >> 3) & 1, f = l & 7; const int pos = a == 0 ? (t >> 6) : (t & 63);
        const float2 cs = rm[pos * 8 + f]; o = v * cs.x + (pp ? pr : -pr) * cs.y; }
      if (lane < 32) KPE[(size_t)r * 32 + l] = f2bf(o); }
  }
}
__device__ __forceinline__ int tok_of(int dir, int j) { return dir == 0 ? j : (j < CTXL ? CTXL - 1 - j : TPB + CTXL - 1 - j); }
__device__ __forceinline__ float logsigf(float g) { return fminf(g, 0.f) - log1pf(expf(-fabsf(g))); }
struct MlLocal { float li0, li1, b0, b1, a0, a1, pe0, pm1, bend; };
__device__ __forceinline__ MlLocal mlstm_local(const float* __restrict__ G, float gbi, float gbf, int dir, int c, int lane) {
  MlLocal o;
  const int j0 = c * 128 + 2 * lane;
  const int t0 = tok_of(dir, j0), t1 = tok_of(dir, j0 + 1);
  o.li0 = G[(size_t)t0 * 16] + gbi; o.li1 = G[(size_t)t1 * 16] + gbi;
  const float lf0 = logsigf(G[(size_t)t0 * 16 + 4] + gbf), lf1 = logsigf(G[(size_t)t1 * 16 + 4] + gbf);
  float incl = lf0 + lf1;
#pragma unroll
  for (int o_ = 1; o_ < 64; o_ <<= 1) { const float v = __shfl_up(incl, o_); if (lane >= o_) incl += v; }
  o.b1 = incl; o.b0 = incl - lf1; o.bend = __shfl(incl, 63);
  o.a0 = o.li0 - o.b0; o.a1 = o.li1 - o.b1;
  float pmx = fmaxf(o.a0, o.a1);
#pragma unroll
  for (int o_ = 1; o_ < 64; o_ <<= 1) { const float v = __shfl_up(pmx, o_); if (lane >= o_) pmx = fmaxf(pmx, v); }
  float excl = __shfl_up(pmx, 1); if (lane == 0) excl = -3.0e38f;
  o.pe0 = fmaxf(excl, o.a0); o.pm1 = pmx;
  return o;
}
__device__ __forceinline__ void mlstm_scal(const Params& p, int chain, LP lds) {
  const int tid = my_tid(), wid = tid >> 6, lane = tid & 63;
  const int dir = chain & 1, h = (chain >> 1) & 3, b = chain >> 3;
  const float* G = (const float*)(p.ws + WS_GATES) + (size_t)b * TPB * 16 + dir * 8 + h;
  float4* SC = (float4*)(p.ws + WS_SCAL) + (size_t)chain * TPB;
  float* DEC = (float*)(p.ws + WS_DEC) + chain * 66;
  const float gbi = p.ml_gate_b[dir * 8 + h], gbf = p.ml_gate_b[dir * 8 + 4 + h];
  LAS float* BE = (LAS float*)lds; LAS float* PMs = BE + 66; LAS float* MC = PMs + 66;
  __syncthreads();
  for (int c = wid; c < 66; c += 8) { const MlLocal l = mlstm_local(G, gbi, gbf, dir, c, lane); if (lane == 63) { BE[c] = l.bend; PMs[c] = l.pm1; } }
  __syncthreads();
  if (tid == 0) { float m = 0.f; for (int c = 0; c < 66; ++c) { MC[c] = m; m = BE[c] + fmaxf(m, PMs[c]); } }
  __syncthreads();
  for (int c = wid; c < 66; c += 8) {
    const MlLocal l = mlstm_local(G, gbi, gbf, dir, c, lane);
    const float m = MC[c];
    const float M0 = fmaxf(m, l.pe0), M1 = fmaxf(m, l.pm1), Ml = fmaxf(m, PMs[c]);
    const int j0 = c * 128 + 2 * lane;
    SC[j0]     = make_float4(expf(l.a0 - Ml), expf(Ml - M0), expf(m - M0), expf(-(l.b0 + M0)));
    SC[j0 + 1] = make_float4(expf(l.a1 - Ml), expf(Ml - M1), expf(m - M1), expf(-(l.b1 + M1)));
    if (lane == 0) DEC[c] = expf(m - Ml);
  }
}
#define PK4(P, BASE, OUT) do { unsigned a0_ = cvtpk(P[BASE + 0], P[BASE + 1]), a1_ = cvtpk(P[BASE + 2], P[BASE + 3]);   \
    unsigned b0_ = cvtpk(P[BASE + 4], P[BASE + 5]), b1_ = cvtpk(P[BASE + 6], P[BASE + 7]);                              \
    auto r0_ = __builtin_amdgcn_permlane32_swap(a0_, b0_, false, false); auto r1_ = __builtin_amdgcn_permlane32_swap(a1_, b1_, false, false); \
    u32x4 w_ = {r0_[0], r1_[0], r0_[1], r1_[1]}; OUT = *reinterpret_cast<bf16x8*>(&w_); } while (0)
#define PKLH(L, H) (bf16x8){L[0], L[1], L[2], L[3], H[0], H[1], H[2], H[3]}
template <int T, int KS>
__device__ __forceinline__ void ml_pv_step(f32x16* acc, int vb_v, bf16x8 pa) {
  const s16x4 l0 = tr_read<T * 16384 + v_rd_off(0, KS, 0)>(vb_v), h0 = tr_read<T * 16384 + v_rd_off(0, KS, 1)>(vb_v);
  const s16x4 l1 = tr_read<T * 16384 + v_rd_off(1, KS, 0)>(vb_v), h1 = tr_read<T * 16384 + v_rd_off(1, KS, 1)>(vb_v);
  asm volatile("s_waitcnt lgkmcnt(0)" ::: "memory"); SBAR();
  acc[0] = __builtin_amdgcn_mfma_f32_32x32x16_bf16(pa, PKLH(l0, h0), acc[0], 0, 0, 0);
  acc[1] = __builtin_amdgcn_mfma_f32_32x32x16_bf16(pa, PKLH(l1, h1), acc[1], 0, 0, 0);
}
template <int T, int KS>
__device__ __forceinline__ void ml_cup_step(f32x16* Cacc, f32x16& nacc, int vb_k, int vb_v, bf16x8 ones) {
  const s16x4 ka = tr_read<T * 16384 + v_rd_off(0, KS, 0)>(vb_k), kh = tr_read<T * 16384 + v_rd_off(0, KS, 1)>(vb_k);
  const s16x4 l0 = tr_read<T * 16384 + v_rd_off(0, KS, 0)>(vb_v), h0 = tr_read<T * 16384 + v_rd_off(0, KS, 1)>(vb_v);
  const s16x4 l1 = tr_read<T * 16384 + v_rd_off(1, KS, 0)>(vb_v), h1 = tr_read<T * 16384 + v_rd_off(1, KS, 1)>(vb_v);
  asm volatile("s_waitcnt lgkmcnt(0)" ::: "memory"); SBAR();
  const bf16x8 af = PKLH(ka, kh);
  Cacc[0] = __builtin_amdgcn_mfma_f32_32x32x16_bf16(af, PKLH(l0, h0), Cacc[0], 0, 0, 0);
  Cacc[1] = __builtin_amdgcn_mfma_f32_32x32x16_bf16(af, PKLH(l1, h1), Cacc[1], 0, 0, 0);
  nacc = __builtin_amdgcn_mfma_f32_32x32x16_bf16(af, ones, nacc, 0, 0, 0);
}
__device__ __forceinline__ void mlstm_chain(const Params& p, int chain, LP lds) {
  const int tid = my_tid(), wid = tid >> 6, lane = tid & 63, r32 = lane & 31, hi = lane >> 5;
  const int tb = wid & 3, eh = wid >> 2, db = wid & 3;
  const int dir = chain & 1, h = (chain >> 1) & 3, b = chain >> 3;
  const LP KR = lds, KT = lds + 32768, VT = lds + 65536, CT = lds + 98304;
  LAS float* NV = (LAS float*)(lds + 131072); LAS float* WSs = NV + 128; LAS float* IFs = WSs + 128; LAS float* DENs = IFs + 128 + wid * 32;
  const bf16_t* MQ = (const bf16_t*)p.out + (size_t)b * TPB * 512 + h * 128;
  const bf16_t* MK = MQ + (size_t)R * 512;
  const bf16_t* VG = (const bf16_t*)(p.ws + WS_P0) + (size_t)b * TPB * P0W + 1440 + h * 128;
  bf16_t* HO = (bf16_t*)(p.ws + (dir == 0 ? WS_HF : WS_HB)) + (size_t)b * TPB * 512 + h * 128;
  const float4* SC = (const float4*)(p.ws + WS_SCAL) + (size_t)chain * TPB;
  const float* DEC = (const float*)(p.ws + WS_DEC) + chain * 66;
  __syncthreads();
  for (int i = tid; i < 2048; i += NTHREADS) *reinterpret_cast<LAS u32x4*>(CT + i * 16) = u32x4{0u, 0u, 0u, 0u};
  if (tid < 128) NV[tid] = 0.f;
  f32x16 Cacc[2], nacc;
  Cacc[0] = f32x16{}; Cacc[1] = f32x16{}; nacc = f32x16{};
  const int sr = tid >> 4, sc = (tid & 15) * 8;
  const int vrb = v_rd_base(lane);
  const int vb_v = (int)(unsigned)(size_t)VT + vrb + eh * 1024;
  const int vb_k = (int)(unsigned)(size_t)KT + vrb + db * 512;
  const short one_s = (short)0x3F80;
  const bf16x8 ones = {one_s, one_s, one_s, one_s, one_s, one_s, one_s, one_s};
  for (int c = 0; c < 66; ++c) {
    const int jb = c * 128;
    bf16x8 kreg[4], vreg[4]; float wks[4];
#pragma unroll
    for (int i = 0; i < 4; ++i) { const int j = jb + sr + 32 * i; const int tt = tok_of(dir, j);
      kreg[i] = *reinterpret_cast<const bf16x8*>(MK + (size_t)tt * 512 + sc);
      vreg[i] = *reinterpret_cast<const bf16x8*>(VG + (size_t)tt * P0W + sc);
      wks[i] = SC[j].x; }
    const int jq = jb + 32 * tb + r32; const int ttq = tok_of(dir, jq);
    bf16x8 qr[8];
#pragma unroll
    for (int d0 = 0; d0 < 8; ++d0) qr[d0] = *reinterpret_cast<const bf16x8*>(MQ + (size_t)ttq * 512 + d0 * 16 + hi * 8);
    const float4 scq = SC[jq];
    float4 s4 = make_float4(0.f, 0.f, 0.f, 0.f);
    if (tid < 128) s4 = SC[jb + tid];
    const float decay = DEC[c];
    __syncthreads();
    if (tid < 128) { WSs[tid] = s4.z; IFs[tid] = s4.w; }
    if (c > 0) {
#pragma unroll
      for (int e1 = 0; e1 < 2; ++e1) { const int erow = 64 * eh + 32 * e1 + r32;
#pragma unroll
        for (int g = 0; g < 4; ++g) { const int d = 32 * db + 8 * g + 4 * hi;
          u32x2 w = {cvtpk(Cacc[e1][4 * g], Cacc[e1][4 * g + 1]), cvtpk(Cacc[e1][4 * g + 2], Cacc[e1][4 * g + 3])};
          *reinterpret_cast<LAS u32x2*>(CT + KSWZ(erow, d * 2)) = w; } }
      if (eh == 0 && r32 == 0) {
#pragma unroll
        for (int r = 0; r < 16; ++r) NV[32 * db + crow(r, hi)] = nacc[r]; }
    }
#pragma unroll
    for (int i = 0; i < 4; ++i) {
      const u32x4 kw = *reinterpret_cast<const u32x4*>(&kreg[i]); const float w = wks[i];
      u32x4 ko;
#pragma unroll
      for (int q = 0; q < 4; ++q) ko[q] = cvtpk(__uint_as_float(kw[q] << 16) * w, __uint_as_float(kw[q] & 0xffff0000u) * w);
      const int row = sr + 32 * i, tl = i >> 1, kin = sr + 32 * (i & 1);
      *reinterpret_cast<LAS u32x4*>(KR + KSWZ(row, sc * 2)) = ko;
      *reinterpret_cast<LAS u32x4*>(KT + tl * 16384 + v_st(kin, sc)) = ko;
      *reinterpret_cast<LAS bf16x8*>(VT + tl * 16384 + v_st(kin, sc)) = vreg[i];
    }
    __syncthreads();
    bf16x8 pa[8]; float dsum = 0.f;
#pragma unroll
    for (int kb = 0; kb < 4; ++kb) {
      if (kb <= tb) {
        f32x16 pp = f32x16{};
#pragma unroll
        for (int d0 = 0; d0 < 8; ++d0) { const int cb = (d0 * 16 + hi * 8) * 2;
          const bf16x8 a = *reinterpret_cast<const LAS bf16x8*>(KR + KSWZ(32 * kb + r32, cb));
          pp = __builtin_amdgcn_mfma_f32_32x32x16_bf16(a, qr[d0], pp, 0, 0, 0); }
#pragma unroll
        for (int r = 0; r < 16; ++r) { const bool ok = (kb < tb) || (crow(r, hi) <= r32); const float v = ok ? pp[r] * scq.y : 0.f; pp[r] = v; dsum += v; }
        PK4(pp, 0, pa[2 * kb]); PK4(pp, 8, pa[2 * kb + 1]);
      } else { pa[2 * kb] = bf16x8{0, 0, 0, 0, 0, 0, 0, 0}; pa[2 * kb + 1] = bf16x8{0, 0, 0, 0, 0, 0, 0, 0}; }
    }
    { auto rr = __builtin_amdgcn_permlane32_swap(__float_as_uint(dsum), __float_as_uint(dsum), false, false);
      dsum = __uint_as_float(rr[0]) + __uint_as_float(rr[1]); }
    f32x16 acc[2]; acc[0] = f32x16{}; acc[1] = f32x16{};
#pragma unroll
    for (int ds = 0; ds < 8; ++ds) { const int cb = (ds * 16 + hi * 8) * 2;
      const bf16x8 c0 = *reinterpret_cast<const LAS bf16x8*>(CT + KSWZ(64 * eh + r32, cb));
      const bf16x8 c1 = *reinterpret_cast<const LAS bf16x8*>(CT + KSWZ(64 * eh + 32 + r32, cb));
      acc[0] = __builtin_amdgcn_mfma_f32_32x32x16_bf16(qr[ds], c0, acc[0], 0, 0, 0);
      acc[1] = __builtin_amdgcn_mfma_f32_32x32x16_bf16(qr[ds], c1, acc[1], 0, 0, 0); }
    float qn = 0.f;
#pragma unroll
    for (int d0 = 0; d0 < 8; ++d0) { const u32x4 qw = *reinterpret_cast<const u32x4*>(&qr[d0]);
#pragma unroll
      for (int q = 0; q < 4; ++q) { qn += __uint_as_float(qw[q] << 16) * NV[d0 * 16 + hi * 8 + 2 * q] + __uint_as_float(qw[q] & 0xffff0000u) * NV[d0 * 16 + hi * 8 + 2 * q + 1]; } }
    { auto rr = __builtin_amdgcn_permlane32_swap(__float_as_uint(qn), __float_as_uint(qn), false, false);
      qn = __uint_as_float(rr[0]) + __uint_as_float(rr[1]); }
    const float den = scq.z * qn + dsum;
    if (hi == 0) DENs[r32] = den;
#pragma unroll
    for (int r = 0; r < 16; ++r) { const float w = WSs[32 * tb + crow(r, hi)]; acc[0][r] *= w; acc[1][r] *= w; }
    ml_pv_step<0, 0>(acc, vb_v, pa[0]); ml_pv_step<0, 1>(acc, vb_v, pa[1]);
    if (tb >= 1) { ml_pv_step<0, 2>(acc, vb_v, pa[2]); ml_pv_step<0, 3>(acc, vb_v, pa[3]); }
    if (tb >= 2) { ml_pv_step<1, 0>(acc, vb_v, pa[4]); ml_pv_step<1, 1>(acc, vb_v, pa[5]); }
    if (tb >= 3) { ml_pv_step<1, 2>(acc, vb_v, pa[6]); ml_pv_step<1, 3>(acc, vb_v, pa[7]); }
    { const int ttb = tok_of(dir, jb), stp = dir ? -1 : 1;
#pragma unroll
      for (int r = 0; r < 16; ++r) { const int t = 32 * tb + crow(r, hi);
        const float rd = 1.f / fmaxf(fabsf(DENs[crow(r, hi)]), IFs[t]);
        bf16_t* o = HO + (size_t)(ttb + stp * t) * 512 + 64 * eh + r32;
        o[0] = f2bf(acc[0][r] * rd); o[32] = f2bf(acc[1][r] * rd); } }
#pragma unroll
    for (int r = 0; r < 16; ++r) { Cacc[0][r] *= decay; Cacc[1][r] *= decay; nacc[r] *= decay; }
    ml_cup_step<0, 0>(Cacc, nacc, vb_k, vb_v, ones); ml_cup_step<0, 1>(Cacc, nacc, vb_k, vb_v, ones);
    ml_cup_step<0, 2>(Cacc, nacc, vb_k, vb_v, ones); ml_cup_step<0, 3>(Cacc, nacc, vb_k, vb_v, ones);
    ml_cup_step<1, 0>(Cacc, nacc, vb_k, vb_v, ones); ml_cup_step<1, 1>(Cacc, nacc, vb_k, vb_v, ones);
    ml_cup_step<1, 2>(Cacc, nacc, vb_k, vb_v, ones); ml_cup_step<1, 3>(Cacc, nacc, vb_k, vb_v, ones);
  }
}
__device__ __forceinline__ void phase_mix0(const Params& p, LP lds) {
  if (blockIdx.x < 32) mlstm_chain(p, blockIdx.x, lds);
  const int tid = my_tid(), sc = (tid & 15) * 8;
  const bf16_t* KV = (const bf16_t*)(p.ws + WS_KV); const bf16_t* QM = (const bf16_t*)(p.ws + WS_QM); const bf16_t* KPE = (const bf16_t*)(p.ws + WS_KPE);
  bf16_t* MIX = (bf16_t*)(p.ws + WS_H);
  const float scale = 0.10206207261596577f;
  const float Cs = scale * 1.4426950408889634f, thr = 8.f / scale;
  int* ctr = (int*)(p.ws + WS_CTR) + (blockIdx.x & 7);
  LAS int* slot = (LAS int*)(lds + 69632);
  for (;;) {
    __syncthreads();
    if (tid == 0) *slot = atomicAdd(ctr, 1);
    __syncthreads();
    const int t = *slot;
    if (t >= 132) break;
    int b, h, row0, seq;
    if (t < 128) { const int bh = (t >> 5) * 8 + (blockIdx.x & 7), qb = t & 31; b = bh >> 3; h = bh & 7; row0 = b * TPB + CTXL + qb * 256; seq = TPB; }
    else { const int bh = (t - 128) * 8 + (blockIdx.x & 7); b = bh >> 3; h = bh & 7; row0 = b * TPB; seq = CTXL; }
    const size_t kb = (size_t)b * TPB;
    const bf16_t* kptr = sc < 64 ? KV + kb * 1024 + h * 128 + sc : KPE + kb * 32 + ((sc - 64) & 31);
    const int kstr = sc < 64 ? 1024 : 32;
    const bf16_t* vptr = KV + kb * 1024 + h * 128 + 64 + (sc & 63);
    attn_body<6, 2>(QM + (size_t)row0 * 768 + h * 96, 768, kptr, kstr, vptr, 1024, MIX + (size_t)row0 * 1024 + h * 64, 1024, seq, Cs, thr, lds);
  }
}
__device__ __forceinline__ void phase_readout(const Params& p) {
  const int lane = my_tid() & 63, gw = blockIdx.x * 8 + (my_tid() >> 6), nw = gridDim.x * 8;
  const bf16_t* P0 = (const bf16_t*)(p.ws + WS_P0); const bf16_t* HF = (const bf16_t*)(p.ws + WS_HF); const bf16_t* HB = (const bf16_t*)(p.ws + WS_HB);
  bf16_t* MIX = (bf16_t*)(p.ws + WS_H);
  for (int r = gw; r < R; r += nw) {
    const int c = lane * 8;
    const u32x4 a = *reinterpret_cast<const u32x4*>(HF + (size_t)r * 512 + c), bb = *reinterpret_cast<const u32x4*>(HB + (size_t)r * 512 + c);
    const u32x4 ov = *reinterpret_cast<const u32x4*>(P0 + (size_t)r * P0W + 1952 + c);
    float hs[8], og[8]; float ss = 0.f;
#pragma unroll
    for (int i = 0; i < 4; ++i) { hs[2 * i] = __uint_as_float(a[i] << 16) + __uint_as_float(bb[i] << 16); hs[2 * i + 1] = __uint_as_float(a[i] & 0xffff0000u) + __uint_as_float(bb[i] & 0xffff0000u);
      og[2 * i] = __uint_as_float(ov[i] << 16); og[2 * i + 1] = __uint_as_float(ov[i] & 0xffff0000u); }
#pragma unroll
    for (int i = 0; i < 8; ++i) ss += hs[i] * hs[i];
    ss += __shfl_xor(ss, 1); ss += __shfl_xor(ss, 2); ss += __shfl_xor(ss, 4); ss += __shfl_xor(ss, 8);
    const float rstd = rsqrtf(ss * (1.f / 128.f) + EPS);
    float o[8];
#pragma unroll
    for (int i = 0; i < 8; ++i) o[i] = sigmoidf(og[i]) * hs[i] * rstd * p.ml_head_norm[c + i];
    u32x4 w = {cvtpk(o[0], o[1]), cvtpk(o[2], o[3]), cvtpk(o[4], o[5]), cvtpk(o[6], o[7])};
    *reinterpret_cast<u32x4*>(MIX + (size_t)r * 1024 + 512 + c) = w;
  }
}
__device__ __forceinline__ void phase_prep1(const Params& p) {
  const int lane = my_tid() & 63, gw = blockIdx.x * 8 + (my_tid() >> 6), nw = gridDim.x * 8;
  bf16_t* Q = (bf16_t*)(p.ws + WS_QKV1);
  const float2* rg = (const float2*)(p.ws + WS_ROPEG);
  const int l16 = lane & 15, a = l16 >> 3, pp = (l16 >> 2) & 1, f0 = (l16 & 3) * 8;
  for (int r = gw; r < R; r += nw) {
    const int b = r / TPB, tt = r - b * TPB;
    const bool isx = tt >= CTXL;
    bf16_t* row = Q + (size_t)r * 1536;
    const int t = tt - CTXL, pos = a == 0 ? (t >> 6) : (t & 63);
#pragma unroll
    for (int ps = 0; ps < 3; ++ps) {
      const int hd = ps * 4 + (lane >> 4);
      const bool act = hd < 10 && (isx || hd >= 8);
      u32x4 w = {0u, 0u, 0u, 0u};
      if (act) w = *reinterpret_cast<const u32x4*>(row + hd * 128 + l16 * 8);
      float y[8]; float ss = 0.f;
#pragma unroll
      for (int q = 0; q < 4; ++q) { y[2 * q] = __uint_as_float(w[q] << 16); y[2 * q + 1] = __uint_as_float(w[q] & 0xffff0000u); ss += y[2 * q] * y[2 * q] + y[2 * q + 1] * y[2 * q + 1]; }
      ss += __shfl_xor(ss, 1); ss += __shfl_xor(ss, 2); ss += __shfl_xor(ss, 4); ss += __shfl_xor(ss, 8);
      const float rstd = rsqrtf(ss * (1.f / 128.f) + EPS);
      const float* gn = (hd < 8 ? p.q_norm1 : p.k_norm1) + l16 * 8;
      float o[8];
#pragma unroll
      for (int j = 0; j < 8; ++j) y[j] = y[j] * rstd * gn[j];
#pragma unroll
      for (int j = 0; j < 8; ++j) { const float pr = __shfl_xor(y[j], 4); float v = y[j];
        if (isx) { const float2 cs = rg[pos * 32 + f0 + j]; v = y[j] * cs.x + (pp ? pr : -pr) * cs.y; }
        o[j] = v; }
      if (act) { u32x4 wo = {cvtpk(o[0], o[1]), cvtpk(o[2], o[3]), cvtpk(o[4], o[5]), cvtpk(o[6], o[7])};
        *reinterpret_cast<u32x4*>(row + hd * 128 + l16 * 8) = wo; }
    }
  }
}
__device__ __forceinline__ void phase_mix1(const Params& p, LP lds) {
  const int tid = my_tid(), sc = (tid & 15) * 8;
  const bf16_t* Q = (const bf16_t*)(p.ws + WS_QKV1); bf16_t* MIX = (bf16_t*)(p.ws + WS_H);
  const float scale = 0.08838834764831845f;
  const float Cs = scale * 1.4426950408889634f, thr = 8.f / scale;
  for (int t = blockIdx.x; t < 1024; t += gridDim.x) {
    const int blkv = t & 255, rnd = t >> 8, bh = rnd * 8 + (blkv & 7), qb = blkv >> 3, b = bh >> 3, h = bh & 7, kvh = h >> 2;
    const int row0 = b * TPB + CTXL + qb * 256;
    const size_t kb = (size_t)b * TPB;
    attn_body<8, 4>(Q + (size_t)row0 * 1536 + h * 128, 1536, Q + kb * 1536 + 1024 + kvh * 128 + sc, 1536, Q + kb * 1536 + 1280 + kvh * 128 + sc, 1536,
                    MIX + (size_t)row0 * 1024 + h * 128, 1024, TPB, Cs, thr, lds);
  }
}
__device__ __forceinline__ void phase_final(const Params& p) {
  const int lane = my_tid() & 63, gw = blockIdx.x * 8 + (my_tid() >> 6), nw = gridDim.x * 8;
  for (int r = gw; r < NB * SEQ; r += nw) {
    float* row = p.out + (size_t)r * DM;
    float4 v[4]; float ss = 0;
#pragma unroll
    for (int i = 0; i < 4; ++i) { v[i] = *reinterpret_cast<const float4*>(row + i * 256 + lane * 4); ss += v[i].x * v[i].x + v[i].y * v[i].y + v[i].z * v[i].z + v[i].w * v[i].w; }
    ss = wave_sum(ss);
    const float rstd = rsqrtf(ss * (1.f / 1024.f) + EPS);
#pragma unroll
    for (int i = 0; i < 4; ++i) { const float4 g = *reinterpret_cast<const float4*>(p.final_norm + i * 256 + lane * 4);
      *reinterpret_cast<float4*>(row + i * 256 + lane * 4) = make_float4(v[i].x * rstd * g.x, v[i].y * rstd * g.y, v[i].z * rstd * g.z, v[i].w * rstd * g.w); }
  }
}

__device__ __forceinline__ void phase_gemm_in0(const Params& p, LP lds) {
  const bf16_t* H = (const bf16_t*)(p.ws + WS_H); const bf16_t* WT = (const bf16_t*)(p.ws + WS_WT0_IN);
  bf16_t* P0 = (bf16_t*)(p.ws + WS_P0); float* G = (float*)(p.ws + WS_GATES);
  bool pre = false;
  for (int t = blockIdx.x; t < 132 * 10; t += gridDim.x) {
    const int mt = t / 10, nt = t % 10, row0 = mt * 256, col0 = nt * 256;
    const int tn = t + gridDim.x; const bool hasn = tn < 132 * 10; const int rown = (tn / 10) * 256, coln = (tn % 10) * 256;
    gemm8p(H + (size_t)row0 * 1024, 1024, WT + (size_t)col0 * 1024, 1024, 1024, lds, [&](int rr, int cc, int hi, f32x16 v) __attribute__((always_inline)) {
      const int col = col0 + cc;
#pragma unroll
      for (int r = 0; r < 16; ++r) { const size_t row = row0 + rr + crow(r, hi);
        if (col < P0W) P0[row * P0W + col] = f2bf(v[r]); else if (col < 2480) G[row * 16 + (col - P0W)] = v[r]; }
    }, pre, hasn ? H + (size_t)rown * 1024 : nullptr, hasn ? WT + (size_t)coln * 1024 : nullptr);
    pre = hasn;
  }
}
__device__ __forceinline__ void phase_gemm_up0(const Params& p, LP lds) {
  const bf16_t* CQN = (const bf16_t*)(p.ws + WS_CQN); const bf16_t* CKVN = (const bf16_t*)(p.ws + WS_CKVN);
  const bf16_t* WQ = (const bf16_t*)(p.ws + WS_WT0_UQ); const bf16_t* WKV = (const bf16_t*)(p.ws + WS_WT0_UKV);
  bf16_t* QM = (bf16_t*)(p.ws + WS_QM); bf16_t* KV = (bf16_t*)(p.ws + WS_KV);
  const float2* rm = (const float2*)(p.ws + WS_ROPEM);
  for (int t = blockIdx.x; t < 132 * 7; t += gridDim.x) {
    const int mt = t / 7, nt = t % 7, row0 = mt * 256;
    if (nt < 3) {
      const int col0 = nt * 256;
      const bool isx = (row0 % TPB) >= CTXL;
      const int tk0 = (row0 % TPB) - CTXL;
      gemm256(CQN + (size_t)row0 * 256, 256, WQ + (size_t)col0 * 256, 256, 256, lds, [&](int rr, int cc, int hi, f32x16 v) __attribute__((always_inline)) {
        const int col = col0 + cc, d = col % 96;
        const bool rot = isx && d >= 64;
        const int idx = d - 64, a = (idx >> 4) & 1, pp = (idx >> 3) & 1, f = idx & 7;
#pragma unroll
        for (int r = 0; r < 16; ++r) { const int row = row0 + rr + crow(r, hi);
          float o = v[r];
          const float pr = __shfl_xor(o, 8);
          if (rot) { const int tk = tk0 + rr + crow(r, hi); const int pos = a == 0 ? (tk >> 6) : (tk & 63); const float2 cs = rm[pos * 8 + f]; o = o * cs.x + (pp ? pr : -pr) * cs.y; }
          QM[(size_t)row * 768 + col] = f2bf(o); }
      });
    } else {
      const int col0 = (nt - 3) * 256;
      gemm256(CKVN + (size_t)row0 * 128, 128, WKV + (size_t)col0 * 128, 128, 128, lds, [&](int rr, int cc, int hi, f32x16 v) __attribute__((always_inline)) {
        const int col = col0 + cc;
#pragma unroll
        for (int r = 0; r < 16; ++r) { const size_t row = row0 + rr + crow(r, hi); KV[row * 1024 + col] = f2bf(v[r]); }
      });
    }
  }
}
__device__ __forceinline__ void phase_gemm_res(const Params& p, int L, const bf16_t* __restrict__ A, int K, const bf16_t* __restrict__ WT, int gate_slot, bool from_input, bool xonly, LP lds) {
  const float* mods = (const float*)(p.ws + WS_MODS) + (size_t)L * 5 * 6144 + gate_slot * 1024;
  auto tile_of = [&](int t, int& row0, int& col0) __attribute__((always_inline)) -> bool {
    if (t >= 512) return false;
    const int tv = t & 255, rnd = t >> 8, xl = tv & 7, lc = tv >> 3;
    row0 = tile_row_x(rnd * 64 + xl * 8 + (lc >> 2)); col0 = (lc & 3) * 256; return true; };
  bool pre = false;
  for (int t = blockIdx.x; t < 512; t += gridDim.x) {
    int row0 = 0, col0 = 0, rown = 0, coln = 0;
    tile_of(t, row0, col0);
    const bool hasn = tile_of(t + gridDim.x, rown, coln);
    const float* gate = mods + (size_t)mod_idx(row0) * 6144;
    const float* resb = from_input ? in_row(p, row0) : s_row(p, row0);
    float* sb = s_row(p, row0);
    gemm8p(A + (size_t)row0 * K, K, WT + (size_t)col0 * K, K, K, lds, [&](int rr, int cc, int hi, f32x16 v) __attribute__((always_inline)) {
      const int col = col0 + cc; const float g = gate[col];
#pragma unroll
      for (int r = 0; r < 16; ++r) { const size_t o = (size_t)(rr + crow(r, hi)) * DM + col; sb[o] = resb[o] + g * v[r]; }
    }, pre, hasn ? A + (size_t)rown * K : nullptr, hasn ? WT + (size_t)coln * K : nullptr);
    pre = hasn;
  }
  if (!xonly) {
    const int ks = K >> 8;
    const float* gate = mods + (size_t)4 * 6144;
    for (int it = blockIdx.x; it < 16 * ks; it += gridDim.x) {
      const int ct = it / ks, sl = it - ct * ks, b = ct >> 2, nt = ct & 3, row0 = b * TPB, col0 = nt * 256, k0 = sl * 256;
      float* sb = (float*)(p.ws + WS_SCTX) + (size_t)b * CTXL * DM;
      gemm8p(A + (size_t)row0 * K + k0, K, WT + (size_t)col0 * K + k0, K, 256, lds, [&](int rr, int cc, int hi, f32x16 v) __attribute__((always_inline)) {
        const int col = col0 + cc; const float g = gate[col];
#pragma unroll
        for (int r = 0; r < 16; ++r) { const size_t o = (size_t)(rr + crow(r, hi)) * DM + col; unsafeAtomicAdd(&sb[o], g * v[r]); }
      });
    }
  }
}
__device__ __forceinline__ void phase_gemm_w1(const Params& p, const bf16_t* __restrict__ WT, bool xonly, LP lds) {
  const bf16_t* H = (const bf16_t*)(p.ws + WS_H); bf16_t* U = (bf16_t*)(p.ws + WS_U);
  const int nmt = xonly ? 128 : 132;
  auto tile_of = [&](int t, int& row0, int& col0) __attribute__((always_inline)) -> bool {
    if (t >= 144 * 16) return false;
    const int tv = t & 255, rnd = t >> 8, xl = tv & 7, lc = tv >> 3;
    const int mt = rnd * 16 + (xl >> 1) * 4 + (lc >> 3), nt = (xl & 1) * 8 + (lc & 7);
    if (mt >= nmt) return false;
    row0 = xonly ? tile_row_x(mt) : tile_row_all(mt); col0 = nt * 256; return true; };
  bool pre = false;
  for (int t = blockIdx.x; t < 144 * 16; t += gridDim.x) {
    int row0 = 0, col0 = 0, rown = 0, coln = 0;
    if (!tile_of(t, row0, col0)) continue;
    const bool hasn = tile_of(t + gridDim.x, rown, coln);
    gemm8p(H + (size_t)row0 * 1024, 1024, WT + (size_t)col0 * 1024, 1024, 1024, lds, [&](int rr, int cc, int hi, f32x16 v) __attribute__((always_inline)) {
      const int col = col0 + cc;
#pragma unroll
      for (int r = 0; r < 16; ++r) { const size_t row = row0 + rr + crow(r, hi); const float a = fmaxf(v[r], 0.f); U[row * 4096 + col] = f2bf(a * a); }
    }, pre, hasn ? H + (size_t)rown * 1024 : nullptr, hasn ? WT + (size_t)coln * 1024 : nullptr);
    pre = hasn;
  }
}
__device__ __forceinline__ void phase_gemm_in1(const Params& p, LP lds) {
  const bf16_t* H = (const bf16_t*)(p.ws + WS_H); const bf16_t* WT = (const bf16_t*)(p.ws + WS_WT1_IN); bf16_t* Q = (bf16_t*)(p.ws + WS_QKV1);
  bool pre = false;
  for (int t = blockIdx.x; t < 132 * 6; t += gridDim.x) {
    const int mt = t / 6, nt = t % 6, row0 = mt * 256, col0 = nt * 256;
    const int tn = t + gridDim.x; const bool hasn = tn < 132 * 6; const int rown = (tn / 6) * 256, coln = (tn % 6) * 256;
    gemm8p(H + (size_t)row0 * 1024, 1024, WT + (size_t)col0 * 1024, 1024, 1024, lds, [&](int rr, int cc, int hi, f32x16 v) __attribute__((always_inline)) {
      const int col = col0 + cc;
#pragma unroll
      for (int r = 0; r < 16; ++r) { const size_t row = row0 + rr + crow(r, hi); Q[row * 1536 + col] = f2bf(v[r]); }
    }, pre, hasn ? H + (size_t)rown * 1024 : nullptr, hasn ? WT + (size_t)coln * 1024 : nullptr);
    pre = hasn;
  }
}

__device__ __forceinline__ void run_phase(const Params& p, int ph, LP lds) {
  char* ws = p.ws;
  switch (ph) {
    case 0: phase_prep(p, lds); break;
    case 1: phase_mods(p); break;
    case 2: phase_norm(p, 0, 0, p.norm1[0], 0, false); break;
    case 3: phase_gemm_in0(p, lds); break;
    case 4: phase_prep0(p, lds); break;
    case 5: phase_gemm_up0(p, lds); break;
    case 6: phase_mix0(p, lds); break;
    case 7: phase_readout(p); break;
    case 8: phase_gemm_res(p, 0, (const bf16_t*)(ws + WS_H), 1024, (const bf16_t*)(ws + WS_WT0_OUT), 2, true, false, lds); break;
    case 9: phase_norm(p, 0, 1, p.norm2[0], 3, false); break;
    case 10: phase_gemm_w1(p, (const bf16_t*)(ws + WS_WT0_W1), false, lds); break;
    case 11: phase_gemm_res(p, 0, (const bf16_t*)(ws + WS_U), 4096, (const bf16_t*)(ws + WS_WT0_W2), 5, false, false, lds); break;
    case 12: phase_norm(p, 1, 1, p.norm1[1], 0, false); break;
    case 13: phase_gemm_in1(p, lds); break;
    case 14: phase_prep1(p); break;
    case 15: phase_mix1(p, lds); break;
    case 16: phase_gemm_res(p, 1, (const bf16_t*)(ws + WS_H), 1024, (const bf16_t*)(ws + WS_WT1_OUT), 2, false, true, lds); break;
    case 17: phase_norm(p, 1, 1, p.norm2[1], 3, true); break;
    case 18: phase_gemm_w1(p, (const bf16_t*)(ws + WS_WT1_W1), true, lds); break;
    case 19: phase_gemm_res(p, 1, (const bf16_t*)(ws + WS_U), 4096, (const bf16_t*)(ws + WS_WT1_W2), 5, false, true, lds); break;
    case 20: phase_final(p); break;
    default: break;
  }
}

#if MEGA
#define XB_TMO      128
#define XB_XCNT(j)  (256  + 64 * (j))
#define XB_XSUB(j)  (1280 + 64 * (j))
#define XB_XGEN(j)  (2304 + 64 * (j))
#define XB_TOP      3328
#define XB_TOPGEN   3392
#define XB_SPIN_CAP (1u << 18)
__device__ __forceinline__ unsigned xb_ld(unsigned* p)              { return __hip_atomic_load(p, __ATOMIC_RELAXED, __HIP_MEMORY_SCOPE_AGENT); }
__device__ __forceinline__ unsigned xb_add(unsigned* p, unsigned v) { return __hip_atomic_fetch_add(p, v, __ATOMIC_RELAXED, __HIP_MEMORY_SCOPE_AGENT); }
__device__ __forceinline__ unsigned xb_xcc_id() { return (unsigned)__builtin_amdgcn_s_getreg((3 << 11) | 20) & 0xFu; }
#define XB_SPIN(cond, bar) do { unsigned _sp = 0; while (cond) { __builtin_amdgcn_s_sleep(1); \
    if ((++_sp & 255u) == 0u) { if (xb_ld(&(bar)[XB_TMO])) break; if (_sp > XB_SPIN_CAP) { atomicAdd(&(bar)[XB_TMO], 1u); break; } } } } while (0)
struct XcdBarrier { unsigned* bar; unsigned x; volatile LAS unsigned* st; };
__device__ __forceinline__ XcdBarrier xcd_barrier_post(unsigned* bar, volatile LAS unsigned* st) {
  XcdBarrier b; b.bar = bar; b.x = xb_xcc_id(); b.st = st;
  if (threadIdx.x == 0) (void)xb_add(&bar[XB_XCNT(b.x)], 1u);
  return b;
}
__device__ __forceinline__ void xcd_barrier_complete(unsigned* bar, unsigned x, unsigned& nloc, unsigned& nx) {
  const unsigned G = gridDim.x;
  unsigned sum, cnt, mine, sp = 0u;
  for (;;) {
    sum = 0u; cnt = 0u; mine = 0u;
#pragma unroll
    for (unsigned j = 0; j < 16; ++j) { const unsigned c = xb_ld(&bar[XB_XCNT(j)]); sum += c; cnt += (c > 0u) ? 1u : 0u; mine = (j == x) ? c : mine; }
    if (sum == G) break;
    __builtin_amdgcn_s_sleep(1);
    if ((++sp & 255u) == 0u) { if (xb_ld(&bar[XB_TMO])) break; if (sp > XB_SPIN_CAP) { atomicAdd(&bar[XB_TMO], 1u); break; } }
  }
  nloc = mine > 0u ? mine : 1u; nx = cnt > 0u ? cnt : 1u;
}
__device__ __forceinline__ void xcd_barrier(const XcdBarrier& b) {
  asm volatile("s_waitcnt vmcnt(0)" ::: "memory");
  __syncthreads();
  if (threadIdx.x == 0) {
    unsigned* bar = b.bar;
    __builtin_amdgcn_s_waitcnt(0);
    unsigned nloc = b.st[0], nx = b.st[1];
    if (nloc == 0u) { xcd_barrier_complete(bar, b.x, nloc, nx); b.st[0] = nloc; b.st[1] = nx; }
    const unsigned old = xb_add(&bar[XB_XSUB(b.x)], 1u);
    const unsigned gen = old / nloc;
    if (old + 1u == (gen + 1u) * nloc) {
      __builtin_amdgcn_fence(__ATOMIC_RELEASE, "agent");
      asm volatile("s_waitcnt vmcnt(0)" ::: "memory");
      const unsigned og = xb_add(&bar[XB_TOP], 1u);
      const unsigned tg = og / nx;
      if (og + 1u == (tg + 1u) * nx) xb_add(&bar[XB_TOPGEN], 1u);
      else XB_SPIN(xb_ld(&bar[XB_TOPGEN]) == tg, bar);
      __builtin_amdgcn_fence(__ATOMIC_ACQUIRE, "agent");
      xb_add(&bar[XB_XGEN(b.x)], 1u);
      asm volatile("s_waitcnt vmcnt(0)" ::: "memory");
    } else {
      XB_SPIN(xb_ld(&bar[XB_XGEN(b.x)]) == gen, bar);
      __builtin_amdgcn_fence(__ATOMIC_ACQUIRE, "agent");
      asm volatile("s_waitcnt vmcnt(0)" ::: "memory");
    }
  }
  __syncthreads();
}
#define PH(n) run_phase(p, n, lds); xcd_barrier(xb);
__global__ void __launch_bounds__(NTHREADS) fwd_kernel(Params p) {
  extern __shared__ __attribute__((aligned(16))) char lds_raw[];
  const LP lds = (LP)lds_raw;
  cg::grid_group grid = cg::this_grid();
  volatile LAS unsigned* xst = (volatile LAS unsigned*)(lds + 135168);
  if (threadIdx.x == 0) { xst[0] = 0u; xst[1] = 0u; }
  __syncthreads();
  const XcdBarrier xb = xcd_barrier_post((unsigned*)(p.ws + WS_XBAR), xst);
  PH(0)
  run_phase(p, 1, lds); grid.sync();
  PH(2) PH(3) PH(4) PH(5) PH(6) PH(7) PH(8) PH(9) PH(10) PH(11) PH(12) PH(13) PH(14) PH(15) PH(16) PH(17) PH(18) PH(19)
  run_phase(p, 20, lds);
}
#else
template <int PHN>
__global__ void __launch_bounds__(NTHREADS) fwd_kernel(Params p) {
  extern __shared__ __attribute__((aligned(16))) char lds_raw[];
  run_phase(p, PHN, (LP)lds_raw);
}
template <int PHN> static void launch_phase(const Params& p, int grid, hipStream_t stream) {
  static bool attr = false;
  if (!attr) { (void)hipFuncSetAttribute((const void*)fwd_kernel<PHN>, hipFuncAttributeMaxDynamicSharedMemorySize, LDS_BYTES); attr = true; }
  hipLaunchKernelGGL(fwd_kernel<PHN>, dim3(grid), dim3(NTHREADS), LDS_BYTES, stream, p);
}
#endif

extern "C" void kernel_launch(void* const* d_in, const int* in_sizes, int n_in, void* d_out, int out_size, void* d_ws, size_t ws_size, hipStream_t stream) {
  static int grid_blocks = 0;
  if (!grid_blocks) {
    if (n_in != 30 || ws_size < WS_NEED || out_size != NB * SEQ * DM) { fprintf(stderr, "kernel_launch: unexpected shapes (n_in %d ws %zu need %zu out %d)\n", n_in, ws_size, (size_t)WS_NEED, out_size); return; }
#if MEGA
    if (hipFuncSetAttribute((const void*)fwd_kernel, hipFuncAttributeMaxDynamicSharedMemorySize, LDS_BYTES) != hipSuccess) { fprintf(stderr, "kernel_launch: LDS attribute failed\n"); return; }
#endif
    int dev = 0, cus = 0;
    (void)hipGetDevice(&dev);
    (void)hipDeviceGetAttribute(&cus, hipDeviceAttributeMultiprocessorCount, dev);
#if MEGA
    int per_cu = 0;
    (void)hipOccupancyMaxActiveBlocksPerMultiprocessor(&per_cu, fwd_kernel, NTHREADS, LDS_BYTES);
    if (per_cu < 1) { fprintf(stderr, "kernel_launch: occupancy query returned %d\n", per_cu); return; }
#endif
    if (cus < 32) { fprintf(stderr, "kernel_launch: too few CUs\n"); return; }
    grid_blocks = cus;
  }
  Params p{};
  const float* const* in = (const float* const*)d_in;
  p.x = in[0]; p.c = in[1]; p.ctx = in[2]; p.c_ctx = in[3];
  p.ada_w[0] = in[4]; p.ada_b[0] = in[5]; p.norm1[0] = in[6]; p.w_in[0] = in[7];
  p.mla_q_norm = in[8]; p.mla_w_uq = in[9]; p.mla_kv_norm = in[10]; p.mla_w_ukv = in[11];
  p.ml_conv = in[12]; p.ml_gate_b = in[13]; p.ml_head_norm = in[14];
  p.w_out[0] = in[15]; p.norm2[0] = in[16]; p.w1[0] = in[17]; p.w2[0] = in[18];
  p.ada_w[1] = in[19]; p.ada_b[1] = in[20]; p.norm1[1] = in[21]; p.w_in[1] = in[22];
  p.q_norm1 = in[23]; p.k_norm1 = in[24]; p.w_out[1] = in[25]; p.norm2[1] = in[26]; p.w1[1] = in[27]; p.w2[1] = in[28];
  p.final_norm = in[29];
  p.out = (float*)d_out; p.ws = (char*)d_ws;
#if MEGA
  (void)hipMemsetAsync((char*)d_ws + WS_BAR, 0, 256 + 3456 * 4, stream);
  void* args[] = {&p};
  hipError_t e = hipLaunchCooperativeKernel((const void*)fwd_kernel, dim3(grid_blocks), dim3(NTHREADS), args, LDS_BYTES, stream);
  if (e != hipSuccess) fprintf(stderr, "cooperative launch failed: %s (grid %d)\n", hipGetErrorString(e), grid_blocks);
#else
  const int g = grid_blocks;
  launch_phase<0>(p, g, stream); launch_phase<1>(p, g, stream); launch_phase<2>(p, g, stream); launch_phase<3>(p, g, stream);
  launch_phase<4>(p, g, stream); launch_phase<5>(p, g, stream); launch_phase<6>(p, g, stream); launch_phase<7>(p, g, stream);
  launch_phase<8>(p, g, stream); launch_phase<9>(p, g, stream); launch_phase<10>(p, g, stream); launch_phase<11>(p, g, stream);
  launch_phase<12>(p, g, stream); launch_phase<13>(p, g, stream); launch_phase<14>(p, g, stream); launch_phase<15>(p, g, stream);
  launch_phase<16>(p, g, stream); launch_phase<17>(p, g, stream); launch_phase<18>(p, g, stream); launch_phase<19>(p, g, stream);
  launch_phase<20>(p, g, stream);
#endif
}
```
